# Optimizing an MI355X kernel written in HIP

```python
import jax, jax.numpy as jnp
from jax import lax
import numpy as np

D_MODEL = 2048
BATCH = 4
SEQ = 2048
DEPTH = 1

MIX_WIDTH = D_MODEL
POOL_WIDTH = D_MODEL // 2
POOL_WINDOWS = (2, 4, 8, 16)
N_POOL_GROUPS = len(POOL_WINDOWS)
POOL_GROUP_DIM = POOL_WIDTH // N_POOL_GROUPS
HGRN_WIDTH = MIX_WIDTH - POOL_WIDTH
HGRN_EXPAND = 128
HGRN_HEADS = HGRN_WIDTH // HGRN_EXPAND
HGRN_HEAD_I = HGRN_WIDTH // HGRN_HEADS
HGRN_QK = HGRN_HEADS * HGRN_EXPAND
IN_WIDTH = POOL_WIDTH + 2 * HGRN_QK + 2 * HGRN_WIDTH
CHUNK = 64
D_FF = 5632
N_MOD = 9
EPS = 1e-6

kernel_name = "hybrid_pool_hgrn2_macaron_adaln"


def rmsnorm(x, w):
    xf = x.astype(jnp.float32)
    y = xf * lax.rsqrt(jnp.mean(xf * xf, axis=-1, keepdims=True) + EPS)
    return (y * w.astype(jnp.float32)).astype(x.dtype)


def modulate(h, shift, scale):
    return h * (1.0 + scale[:, None, :]) + shift[:, None, :]


def swiglu(h, w_gate, w_up, w_down):
    return (jax.nn.silu(h @ w_gate) * (h @ w_up)) @ w_down


def causal_multiscale_pool(u):
    B, S, G, Cg = u.shape
    uf = u.astype(jnp.float32)
    wmax = max(POOL_WINDOWS)
    cs = jnp.cumsum(uf, axis=1)
    csp = jnp.pad(cs, ((0, 0), (wmax, 0), (0, 0), (0, 0)))
    t = jnp.arange(S)
    means = []
    for g, w in enumerate(POOL_WINDOWS):
        win = csp[:, wmax:, g] - csp[:, wmax - w:wmax - w + S, g]
        cnt = jnp.minimum(t + 1, w).astype(jnp.float32)
        means.append(win / cnt[None, :, None])
    mean = jnp.stack(means, axis=2)
    return (mean - uf).astype(u.dtype)


def hgrn2_chunk_scan(q, k, v, logf):
    B, S, H, Dk = q.shape
    Dv = v.shape[-1]
    N = S // CHUNK

    def to_chunks(a):
        return a.reshape(B, N, CHUNK, H, a.shape[-1]).transpose(1, 0, 3, 2, 4)

    qc, kc, vc, gc = to_chunks(q), to_chunks(k), to_chunks(v), to_chunks(logf)
    causal = jnp.tril(jnp.ones((CHUNK, CHUNK), dtype=bool))

    def step(s_prev, inp):
        qb, kb, vb, gb = inp
        b = jnp.cumsum(gb, axis=2)
        diff = b[:, :, :, None, :] - b[:, :, None, :, :]
        decay = jnp.exp(jnp.where(causal[:, :, None], diff, -jnp.inf))
        attn = jnp.einsum('bhtd,bhsd,bhtsd->bhts', qb, kb, decay)
        o = (jnp.einsum('bhts,bhsv->bhtv', attn, vb)
             + jnp.einsum('bhtd,bhdv->bhtv', qb * jnp.exp(b), s_prev))
        b_last = b[:, :, -1:, :]
        s_new = (jnp.exp(b_last[:, :, 0, :])[..., None] * s_prev
                 + jnp.einsum('bhsd,bhsv->bhdv', kb * jnp.exp(b_last - b), vb))
        return s_new, o

    s0 = jnp.zeros((B, H, Dk, Dv), jnp.float32)
    _, o = lax.scan(step, s0, (qc, kc, vc, gc))
    return o.transpose(1, 0, 3, 2, 4).reshape(B, S, H, Dv)


def setup_inputs(seed: int = 0) -> dict:
    key = jax.random.key(seed)
    ks = jax.random.split(key, 20)
    L, D = DEPTH, D_MODEL
    nrm = jax.random.normal
    return {
        "x": nrm(ks[0], (BATCH, SEQ, D), jnp.float32),
        "c": nrm(ks[1], (BATCH, D), jnp.float32),
        "w_ada": nrm(ks[2], (L, D, N_MOD * D), jnp.float32) * (0.5 * D ** -0.5),
        "b_ada": nrm(ks[3], (L, N_MOD * D), jnp.float32) * 0.01,
        "norm1_w": 1.0 + 0.02 * nrm(ks[4], (L, D), jnp.float32),
        "ffn1_gate": nrm(ks[5], (L, D, D_FF), jnp.float32) * D ** -0.5,
        "ffn1_up": nrm(ks[6], (L, D, D_FF), jnp.float32) * D ** -0.5,
        "ffn1_down": nrm(ks[7], (L, D_FF, D), jnp.float32) * D_FF ** -0.5,
        "norm2_w": 1.0 + 0.02 * nrm(ks[8], (L, D), jnp.float32),
        "w_in": nrm(ks[9], (L, D, IN_WIDTH), jnp.float32) * D ** -0.5,
        "pool_w": nrm(ks[10], (L, N_POOL_GROUPS, POOL_GROUP_DIM, POOL_GROUP_DIM), jnp.float32) * POOL_GROUP_DIM ** -0.5,
        "pool_scale": 1.0 + 0.1 * nrm(ks[11], (L, POOL_WIDTH), jnp.float32),
        "lb_logits": 0.1 * nrm(ks[12], (L + 1, HGRN_QK), jnp.float32),
        "gnorm_w": 1.0 + 0.02 * nrm(ks[13], (L, HGRN_HEAD_I), jnp.float32),
        "w_out": nrm(ks[14], (L, MIX_WIDTH, D), jnp.float32) * MIX_WIDTH ** -0.5,
        "norm3_w": 1.0 + 0.02 * nrm(ks[15], (L, D), jnp.float32),
        "ffn2_gate": nrm(ks[16], (L, D, D_FF), jnp.float32) * D ** -0.5,
        "ffn2_up": nrm(ks[17], (L, D, D_FF), jnp.float32) * D ** -0.5,
        "ffn2_down": nrm(ks[18], (L, D_FF, D), jnp.float32) * D_FF ** -0.5,
        "final_norm_w": 1.0 + 0.02 * nrm(ks[19], (D,), jnp.float32),
    }


def reference(x, c, w_ada, b_ada, norm1_w, ffn1_gate, ffn1_up, ffn1_down, norm2_w, w_in,
              pool_w, pool_scale, lb_logits, gnorm_w, w_out, norm3_w, ffn2_gate, ffn2_up,
              ffn2_down, final_norm_w):
    B, S, _ = x.shape
    p = jax.nn.softmax(lb_logits.astype(jnp.float32), axis=0)
    lb_all = jnp.cumsum(p, axis=0) - p[0]
    c_act = jax.nn.silu(c)
    splits = [POOL_WIDTH, POOL_WIDTH + HGRN_QK, POOL_WIDTH + 2 * HGRN_QK,
              POOL_WIDTH + 2 * HGRN_QK + HGRN_WIDTH]

    for l in range(DEPTH):
        mod = c_act @ w_ada[l] + b_ada[l]
        sh1, sc1, g1, sh2, sc2, g2, sh3, sc3, g3 = jnp.split(mod, N_MOD, axis=-1)

        h = modulate(rmsnorm(x, norm1_w[l]), sh1, sc1)
        x = x + 0.5 * g1[:, None, :] * swiglu(h, ffn1_gate[l], ffn1_up[l], ffn1_down[l])

        h = modulate(rmsnorm(x, norm2_w[l]), sh2, sc2)
        z = h @ w_in[l]
        zp, zq, zf, zi, zg = jnp.split(z, splits, axis=-1)

        u = zp.reshape(B, S, N_POOL_GROUPS, POOL_GROUP_DIM)
        pooled = causal_multiscale_pool(u)
        y_pool = (jnp.einsum('bsgc,gcd->bsgd', pooled, pool_w[l]).reshape(B, S, POOL_WIDTH)
                  * pool_scale[l])

        lb = lb_all[l + 1]
        forget = lb + (1.0 - lb) * jax.nn.sigmoid(zf.astype(jnp.float32))
        qh = jax.nn.silu(zq.astype(jnp.float32)).reshape(B, S, HGRN_HEADS, HGRN_EXPAND)
        kh = (1.0 - forget).reshape(B, S, HGRN_HEADS, HGRN_EXPAND)
        gh = jnp.log(forget).reshape(B, S, HGRN_HEADS, HGRN_EXPAND)
        vh = zi.astype(jnp.float32).reshape(B, S, HGRN_HEADS, HGRN_HEAD_I)
        o = hgrn2_chunk_scan(qh, kh, vh, gh)
        o = rmsnorm(o, gnorm_w[l]) * jax.nn.silu(
            zg.astype(jnp.float32).reshape(B, S, HGRN_HEADS, HGRN_HEAD_I))
        y_hgrn = o.reshape(B, S, HGRN_WIDTH).astype(x.dtype)

        mix = jnp.concatenate([y_pool.astype(x.dtype), y_hgrn], axis=-1) @ w_out[l]
        x = x + g2[:, None, :] * mix

        h = modulate(rmsnorm(x, norm3_w[l]), sh3, sc3)
        x = x + 0.5 * g3[:, None, :] * swiglu(h, ffn2_gate[l], ffn2_up[l], ffn2_down[l])

    return rmsnorm(x, final_norm_w)
```

```cpp
#include <hip/hip_runtime.h>
#include <hip/hip_cooperative_groups.h>
#include <cstdio>
#include <cstdint>
namespace cg = cooperative_groups;
namespace pg8 {
#define PG8_LAS __attribute__((address_space(3)))
typedef unsigned short bf16_t;
typedef short bf16x8 __attribute__((ext_vector_type(8)));
typedef float f32x4 __attribute__((ext_vector_type(4)));
typedef unsigned u32x4 __attribute__((ext_vector_type(4)));
constexpr int BM = 256, BK = 64, HALF = 128, HTB = HALF * BK * 2  , STAGE_BYTES = 8 * HTB, NXCD = 8, WGM = 8;

__host__ __device__ __forceinline__ int lds_byte(int r, int c) { const int st = (r >> 4) * 2 + (c >> 5), rr = r & 15, cc = c & 31, ob = rr * 64 + cc * 2; return st * 1024 + (ob ^ (((ob >> 9) & 1) << 5)); }
__host__ __device__ __forceinline__ void stage_rc(int b, int& R, int& C) { const int st = b / 1024, sb = b % 1024, swz = sb ^ (((sb >> 9) & 1) << 5); R = (st >> 1) * 16 + swz / 64; C = (st & 1) * 32 + (swz % 64) / 2; }
__host__ __device__ __forceinline__ int perm32(int rho) { const int n = rho >> 4, i = rho & 15; return 8 * (i >> 2) + 4 * n + (i & 3); }

struct Unit { int pm, pn; };
struct Gemm { const bf16_t* A; const bf16_t* Bt; int M, N, K; };

struct StaticOrder {
    int nM, nN, nwg, G, c;
    __host__ __device__ void init(int M, int N, int G_, int c_) { nM = M / BM; nN = N / BM; nwg = nM * nN; G = G_; c = c_; }
    __host__ __device__ bool next(int i, Unit& u) const {
        const long L = (long)i * G + c; if (L >= nwg) return false;
        int wgid = (int)L; { const int q = nwg / NXCD, r = nwg % NXCD, xcd = wgid % NXCD, off = wgid / NXCD; wgid = (xcd < r ? xcd * (q + 1) : r * (q + 1) + (xcd - r) * q) + off; }
        const int nig = WGM * nN, gid = wgid / nig, fm = gid * WGM, gsz = (nM - fm) < WGM ? (nM - fm) : WGM;
        u.pm = fm + ((wgid % nig) % gsz); u.pn = (wgid % nig) / gsz; return true;
    }
    __device__ __forceinline__ void a_ready(const Unit&) const {}
    __device__ __forceinline__ void done(const Unit&) const {}
};

__device__ __forceinline__ unsigned cvt_pk_bf16(float lo, float hi) { unsigned r; asm volatile("v_cvt_pk_bf16_f32 %0, %1, %2" : "=v"(r) : "v"(lo), "v"(hi)); return r; }
typedef float f32x2 __attribute__((ext_vector_type(2)));
template <class Epi, class Sched, bool ALIGN_EPI = false, bool SP2 = false>
__device__ __forceinline__ void gemm_phase(PG8_LAS unsigned char* lds, const Gemm g, const Sched& S, const Epi& E) {
    const int tid = threadIdx.x, wid = __builtin_amdgcn_readfirstlane(tid >> 6), lane = tid & 63, wr = wid >> 2, wc = wid & 3, fr = lane & 15, fq = lane >> 4;
    const int K = g.K, nt = K / BK;
    unsigned voffA[2], voffB[2];
#pragma unroll
    for (int i = 0; i < 2; ++i) { int R, C; stage_rc(tid * 16 + i * 8192, R, C); const int Rb = Epi::PERM ? ((R & ~31) + perm32(R & 31)) : R;
        voffA[i] = (unsigned)(R * K + C) * 2u; voffB[i] = (unsigned)(Rb * K + C) * 2u; }
    const size_t kstep = (size_t)(BK * 2);
    const size_t hstep = (size_t)HALF * K * 2;
    const size_t tstep = 2 * hstep;
    const unsigned ldsw = (unsigned)wid * 1024u;
    const int aoff = lds_byte(wr * 64 + fr, fq * 8), boff = lds_byte(wc * 32 + fr, fq * 8);
#define PG8_SA(b, h) (((b) * 2 + (h)) * HTB)
#define PG8_SB(b, h) ((4 + (b) * 2 + (h)) * HTB)
#define PG8_STAGE(bufoff, gbase, voff) do { _Pragma("unroll") for (int _i = 0; _i < 2; ++_i) \
        __builtin_amdgcn_global_load_lds((const unsigned*)((const char*)(gbase) + (voff)[_i]), (PG8_LAS unsigned*)(lds + (bufoff) + ldsw + _i * 8192), 16, 0, 0); } while (0)
#define PG8_LDA(dst, b, h) do { _Pragma("unroll") for (int m = 0; m < 4; ++m) _Pragma("unroll") for (int k = 0; k < 2; ++k) dst[m][k] = *(const PG8_LAS bf16x8*)(lds + PG8_SA(b, h) + aoff + m * 2048 + k * 1024); } while (0)
#define PG8_LDB(dst, b, h) do { _Pragma("unroll") for (int n = 0; n < 2; ++n) _Pragma("unroll") for (int k = 0; k < 2; ++k) dst[n][k] = *(const PG8_LAS bf16x8*)(lds + PG8_SB(b, h) + boff + n * 2048 + k * 1024); } while (0)
#define PG8_MMA(ai, bj, At, Bt) do { __builtin_amdgcn_s_setprio(1); _Pragma("unroll") for (int m = 0; m < 4; ++m) _Pragma("unroll") for (int n = 0; n < 2; ++n) _Pragma("unroll") for (int k = 0; k < 2; ++k) \
        acc[ai][bj][m][n] = __builtin_amdgcn_mfma_f32_16x16x32_bf16(Bt[n][k], At[m][k], acc[ai][bj][m][n], 0, 0, 0); __builtin_amdgcn_s_setprio(0); } while (0)
#define PG8_WAIT_V(n) asm volatile("s_waitcnt vmcnt(" #n ")" ::: "memory")
#define PG8_WAIT_L(n) asm volatile("s_waitcnt lgkmcnt(" #n ")" ::: "memory")
#define PG8_BAR __builtin_amdgcn_s_barrier()
#define PG8_SCHED __builtin_amdgcn_sched_barrier(0)
    Unit cur, nxt; int ui = 0;
    if (!S.next(0, cur)) return;
    f32x4 acc[2][2][4][2];
#pragma unroll
    for (int a = 0; a < 2; ++a)
#pragma unroll
        for (int b = 0; b < 2; ++b)
#pragma unroll
            for (int m = 0; m < 4; ++m)
#pragma unroll
                for (int n = 0; n < 2; ++n) acc[a][b][m][n] = (f32x4){0.f, 0.f, 0.f, 0.f};
    bf16x8 At[4][2], B0[2][2], B1[2][2];
    const char* cA = (const char*)g.A + (size_t)cur.pm * tstep; const char* cB = (const char*)g.Bt + (size_t)cur.pn * tstep;
    S.a_ready(cur);
    if constexpr (SP2) {
        PG8_STAGE(PG8_SB(0, 0), cB, voffB); PG8_STAGE(PG8_SB(0, 1), cB + hstep, voffB); PG8_STAGE(PG8_SA(0, 0), cA, voffA); PG8_STAGE(PG8_SA(0, 1), cA + hstep, voffA);
        if (wr == 1) PG8_BAR;
        PG8_WAIT_V(2); PG8_BAR;
        PG8_STAGE(PG8_SB(1, 0), cB + kstep, voffB); PG8_STAGE(PG8_SA(1, 0), cA + kstep, voffA); PG8_STAGE(PG8_SB(1, 1), cB + hstep + kstep, voffB);
        PG8_WAIT_V(6); PG8_BAR;
    } else {
        PG8_STAGE(PG8_SB(0, 0), cB, voffB); PG8_STAGE(PG8_SA(0, 0), cA, voffA); PG8_STAGE(PG8_SB(0, 1), cB + hstep, voffB); PG8_STAGE(PG8_SA(0, 1), cA + hstep, voffA);
        if (wr == 1) PG8_BAR;
        PG8_WAIT_V(4); PG8_BAR;
        PG8_STAGE(PG8_SB(1, 0), cB + kstep, voffB); PG8_STAGE(PG8_SA(1, 0), cA + kstep, voffA); PG8_STAGE(PG8_SB(1, 1), cB + hstep + kstep, voffB);
        PG8_WAIT_V(6); PG8_BAR;
    }
    for (;;) {
        const bool has_next = S.next(ui + 1, nxt);
        const char* nA = has_next ? (const char*)g.A + (size_t)nxt.pm * tstep : cA; const char* nB = has_next ? (const char*)g.Bt + (size_t)nxt.pn * tstep : cB;
        for (int t = 0; t < nt; t += 2) {
            const bool last = (t == nt - 2);
            const char* a1 = cA + (size_t)(t + 1) * kstep;
            const char* a2 = last ? nA : cA + (size_t)(t + 2) * kstep; const char* b2 = last ? nB : cB + (size_t)(t + 2) * kstep;
            const char* a3 = a2 + kstep; const char* b3 = b2 + kstep;
            if (last && has_next) S.a_ready(nxt);
            if constexpr (SP2) {
            PG8_LDB(B0, 0, 0); PG8_LDB(B1, 0, 1); PG8_SCHED; PG8_LDA(At, 0, 0); PG8_STAGE(PG8_SA(1, 1), a1 + hstep, voffA);
            PG8_WAIT_V(8); PG8_WAIT_L(0); PG8_BAR; PG8_MMA(0, 0, At, B0); PG8_MMA(0, 1, At, B1); PG8_BAR; PG8_SCHED;
            PG8_LDA(At, 0, 1); PG8_STAGE(PG8_SB(0, 0), b2, voffB); PG8_STAGE(PG8_SB(0, 1), b2 + hstep, voffB); PG8_STAGE(PG8_SA(0, 0), a2, voffA);
            PG8_WAIT_V(8); PG8_WAIT_L(0); PG8_BAR; PG8_MMA(1, 0, At, B0); PG8_MMA(1, 1, At, B1); PG8_BAR; PG8_SCHED;
            PG8_LDB(B0, 1, 0); PG8_LDB(B1, 1, 1); PG8_SCHED; PG8_LDA(At, 1, 0); PG8_STAGE(PG8_SA(0, 1), a2 + hstep, voffA);
            PG8_WAIT_V(8); PG8_WAIT_L(0); PG8_BAR; PG8_MMA(0, 0, At, B0); PG8_MMA(0, 1, At, B1); PG8_BAR; PG8_SCHED;
            PG8_LDA(At, 1, 1); PG8_STAGE(PG8_SB(1, 0), b3, voffB); PG8_STAGE(PG8_SB(1, 1), b3 + hstep, voffB); PG8_STAGE(PG8_SA(1, 0), a3, voffA);
            PG8_WAIT_V(8); PG8_WAIT_L(0); PG8_BAR; PG8_MMA(1, 0, At, B0); PG8_MMA(1, 1, At, B1); PG8_BAR; PG8_SCHED;
            } else {
            PG8_LDB(B0, 0, 0); PG8_SCHED; PG8_LDA(At, 0, 0); PG8_STAGE(PG8_SA(1, 1), a1 + hstep, voffA);
            PG8_WAIT_L(8); PG8_BAR; PG8_WAIT_L(0); PG8_MMA(0, 0, At, B0); PG8_BAR; PG8_SCHED;
            PG8_LDB(B1, 0, 1); PG8_STAGE(PG8_SB(0, 0), b2, voffB);
            PG8_BAR; PG8_WAIT_L(0); PG8_MMA(0, 1, At, B1); PG8_BAR;
            PG8_LDA(At, 0, 1); PG8_STAGE(PG8_SA(0, 0), a2, voffA);
            PG8_BAR; PG8_WAIT_L(0); PG8_MMA(1, 0, At, B0); PG8_BAR; PG8_SCHED;
            PG8_STAGE(PG8_SB(0, 1), b2 + hstep, voffB);
            PG8_WAIT_V(6); PG8_BAR; PG8_MMA(1, 1, At, B1); PG8_BAR;
            PG8_LDB(B0, 1, 0); PG8_SCHED; PG8_LDA(At, 1, 0); PG8_STAGE(PG8_SA(0, 1), a2 + hstep, voffA);
            PG8_WAIT_L(8); PG8_BAR; PG8_WAIT_L(0); PG8_MMA(0, 0, At, B0); PG8_BAR; PG8_SCHED;
            PG8_LDB(B1, 1, 1); PG8_STAGE(PG8_SB(1, 0), b3, voffB);
            PG8_BAR; PG8_WAIT_L(0); PG8_MMA(0, 1, At, B1); PG8_BAR;
            PG8_LDA(At, 1, 1); PG8_STAGE(PG8_SA(1, 0), a3, voffA);
            PG8_BAR; PG8_WAIT_L(0); PG8_MMA(1, 0, At, B0); PG8_BAR; PG8_SCHED;
            PG8_STAGE(PG8_SB(1, 1), b3 + hstep, voffB);
            PG8_WAIT_V(6); PG8_BAR; PG8_MMA(1, 1, At, B1); PG8_BAR;
            }
        }
        if constexpr (ALIGN_EPI) { if (wr == 0) PG8_BAR; }
        if constexpr (!Epi::AFTER_DRAIN) { E(acc, cur, wr, wc, fr, fq); S.done(cur); }
        if (!has_next) break;
#pragma unroll
        for (int a = 0; a < 2; ++a)
#pragma unroll
            for (int b = 0; b < 2; ++b)
#pragma unroll
                for (int m = 0; m < 4; ++m)
#pragma unroll
                    for (int n = 0; n < 2; ++n) acc[a][b][m][n] = (f32x4){0.f, 0.f, 0.f, 0.f};
        cur = nxt; cA = nA; cB = nB; ++ui;
        if constexpr (ALIGN_EPI) { if (wr == 1) PG8_BAR; }
    }
    PG8_WAIT_V(0);
    if constexpr (!ALIGN_EPI) { if (wr == 0) PG8_BAR; }
    PG8_BAR;
    if constexpr (Epi::AFTER_DRAIN) { E.fused(acc, cur, wr, wc, fr, fq, lds, wid, lane); S.done(cur); }
#undef PG8_SA
#undef PG8_SB
#undef PG8_STAGE
#undef PG8_LDA
#undef PG8_LDB
#undef PG8_MMA
#undef PG8_WAIT_V
#undef PG8_WAIT_L
#undef PG8_BAR
#undef PG8_SCHED
}
}

#ifndef MK_N_LAUNCHES
#define MK_N_LAUNCHES 1
#endif

constexpr int NB = 4, SEQ = 2048, DM = 2048, MT = NB * SEQ;
constexpr int DFF = 5632, NMODC = 9 * DM;
constexpr int PW = 1024, HQK = 1024, INW = 5120;
constexpr float EPS = 1e-6f;
constexpr int NPH = 14;
enum { PH_PRO = 0, PH_N1, PH_GU1, PH_DN1, PH_N2, PH_WIN, PH_MIXA, PH_SCAN, PH_MIXB, PH_WOUT, PH_N3, PH_GU2, PH_DN2, PH_FIN };

constexpr size_t MiB = 1u << 20;
constexpr size_t WS_MOD = 0, WS_LB = MiB / 2, WS_ADEC = 1 * MiB, WS_PWT = 3 * MiB / 2;
constexpr size_t WS_WGU1 = 2 * MiB, WS_WD1 = 46 * MiB, WS_WIN = 68 * MiB, WS_WOUT = 88 * MiB, WS_WGU2 = 96 * MiB, WS_WD2 = 140 * MiB;
constexpr size_t WS_H = 162 * MiB, WS_X = 194 * MiB, WS_MIX = 258 * MiB, WS_HID = 290 * MiB, WS_ST = 290 * MiB  ;
constexpr size_t WS_ZP = 378 * MiB, WS_ZQ = 394 * MiB, WS_ZK = 410 * MiB, WS_ZV = 426 * MiB, WS_ZS = 442 * MiB, WS_ZG = 458 * MiB, WS_END = 490 * MiB;
constexpr int LDS_BYTES = 143360;

#define LAS __attribute__((address_space(3)))
typedef unsigned short bf16_t;
typedef float f32x4 __attribute__((ext_vector_type(4)));
typedef unsigned u32x4 __attribute__((ext_vector_type(4)));
typedef unsigned u32x2 __attribute__((ext_vector_type(2)));
typedef short bf16x8 __attribute__((ext_vector_type(8)));

__device__ __forceinline__ float bf2f(unsigned h) { return __uint_as_float(h << 16); }
__device__ __forceinline__ unsigned pk2(float lo, float hi) { return pg8::cvt_pk_bf16(lo, hi); }
__device__ __forceinline__ float silu_f(float x) { return x * __builtin_amdgcn_rcpf(1.0f + __expf(-x)); }
__device__ __forceinline__ float wave_sum(float v) {
#pragma unroll
    for (int o = 1; o < 64; o <<= 1) v += __shfl_xor(v, o);
    return v;
}

namespace pg8 {
struct EpiSwiglu {
    static constexpr bool PERM = true, AFTER_DRAIN = false;
    bf16_t* O; int ldc;
    __device__ __forceinline__ void operator()(const f32x4 (&acc)[2][2][4][2], const Unit& u, int wr, int wc, int fr, int fq) const {
        const int row0 = u.pm * BM + wr * 64 + fr, col0 = u.pn * HALF + wc * 32 + 8 * fq;
#pragma unroll
        for (int ai = 0; ai < 2; ++ai)
#pragma unroll
            for (int m = 0; m < 4; ++m) {
                bf16_t* rowp = O + (size_t)(row0 + ai * HALF + m * 16) * ldc + col0;
                const f32x4 g0 = acc[ai][0][m][0], g1 = acc[ai][0][m][1], u0 = acc[ai][1][m][0], u1 = acc[ai][1][m][1];
                u32x4 w;
                w.x = cvt_pk_bf16(silu_f(g0[0]) * u0[0], silu_f(g0[1]) * u0[1]); w.y = cvt_pk_bf16(silu_f(g0[2]) * u0[2], silu_f(g0[3]) * u0[3]);
                w.z = cvt_pk_bf16(silu_f(g1[0]) * u1[0], silu_f(g1[1]) * u1[1]); w.w = cvt_pk_bf16(silu_f(g1[2]) * u1[2], silu_f(g1[3]) * u1[3]);
                *(u32x4*)rowp = w;
            }
    }
};
struct EpiResid {
    static constexpr bool PERM = true, AFTER_DRAIN = false;
    const float* Xin; float* Xout; const float* gate; float coef;
    __device__ __forceinline__ void operator()(const f32x4 (&acc)[2][2][4][2], const Unit& u, int wr, int wc, int fr, int fq) const {
        const int row0 = u.pm * BM + wr * 64 + fr, col0 = u.pn * BM + wc * 32 + 8 * fq;
        const float* gp = gate + (size_t)(u.pm >> 3) * NMODC + col0;
        f32x4 gv[2][2];
#pragma unroll
        for (int bj = 0; bj < 2; ++bj)
#pragma unroll
            for (int n = 0; n < 2; ++n) gv[bj][n] = *(const f32x4*)(gp + bj * HALF + 4 * n) * coef;
#pragma unroll
        for (int ai = 0; ai < 2; ++ai)
#pragma unroll
            for (int m = 0; m < 4; ++m) {
                const size_t off = (size_t)(row0 + ai * HALF + m * 16) * DM + col0;
#pragma unroll
                for (int bj = 0; bj < 2; ++bj)
#pragma unroll
                    for (int n = 0; n < 2; ++n) {
                        const f32x4 xi = *(const f32x4*)(Xin + off + bj * HALF + 4 * n);
                        *(f32x4*)(Xout + off + bj * HALF + 4 * n) = xi + gv[bj][n] * acc[ai][bj][m][n];
                    }
                asm volatile("" ::: "memory");
            }
    }
};
struct EpiWin {
    static constexpr bool PERM = true, AFTER_DRAIN = false;
    bf16_t *ZP, *ZQ, *ZK, *ZV, *ZS; float* ZG; const float* lb;
    __device__ __forceinline__ void operator()(const f32x4 (&acc)[2][2][4][2], const Unit& u, int wr, int wc, int fr, int fq) const {
        const int seg = u.pn >> 2;
        const int row0 = u.pm * BM + wr * 64 + fr, col0 = (u.pn & 3) * BM + wc * 32 + 8 * fq;
        bf16_t* O = seg == 0 ? ZP : seg == 1 ? ZQ : seg == 2 ? ZK : seg == 3 ? ZV : ZS;
        if (seg == 2) {
#pragma unroll
            for (int bj = 0; bj < 2; ++bj) {
                const f32x4 l0 = *(const f32x4*)(lb + col0 + bj * HALF), l1 = *(const f32x4*)(lb + col0 + bj * HALF + 4);
#pragma unroll
                for (int ai = 0; ai < 2; ++ai)
#pragma unroll
                    for (int m = 0; m < 4; ++m) {
                        const size_t off = (size_t)(row0 + ai * HALF + m * 16) * HQK + col0 + bj * HALF;
                        float kk[8], gg[8];
#pragma unroll
                        for (int j = 0; j < 8; ++j) {
                            const float z = j < 4 ? acc[ai][bj][m][0][j & 3] : acc[ai][bj][m][1][j & 3];
                            const float lbv = j < 4 ? l0[j & 3] : l1[j & 3];
                            const float e = __expf(-z);
                            const float r = __builtin_amdgcn_rcpf(1.0f + e);
                            const float sg = r, sgc = (e > 3.0e38f) ? 1.0f : e * r;
                            const float forget = lbv + (1.0f - lbv) * sg;
                            kk[j] = (1.0f - lbv) * sgc;
                            gg[j] = logf(forget);
                        }
                        u32x4 w; w.x = cvt_pk_bf16(kk[0], kk[1]); w.y = cvt_pk_bf16(kk[2], kk[3]); w.z = cvt_pk_bf16(kk[4], kk[5]); w.w = cvt_pk_bf16(kk[6], kk[7]);
                        *(u32x4*)(O + off) = w;
                        *(f32x4*)(ZG + off) = (f32x4){gg[0], gg[1], gg[2], gg[3]};
                        *(f32x4*)(ZG + off + 4) = (f32x4){gg[4], gg[5], gg[6], gg[7]};
                    }
            }
        } else {
            const bool act = (seg == 1) || (seg == 4);
#pragma unroll
            for (int ai = 0; ai < 2; ++ai)
#pragma unroll
                for (int m = 0; m < 4; ++m)
#pragma unroll
                    for (int bj = 0; bj < 2; ++bj) {
                        f32x4 v0 = acc[ai][bj][m][0], v1 = acc[ai][bj][m][1];
                        if (act) { v0 = (f32x4){silu_f(v0[0]), silu_f(v0[1]), silu_f(v0[2]), silu_f(v0[3])}; v1 = (f32x4){silu_f(v1[0]), silu_f(v1[1]), silu_f(v1[2]), silu_f(v1[3])}; }
                        u32x4 w; w.x = cvt_pk_bf16(v0[0], v0[1]); w.y = cvt_pk_bf16(v0[2], v0[3]); w.z = cvt_pk_bf16(v1[0], v1[1]); w.w = cvt_pk_bf16(v1[2], v1[3]);
                        *(u32x4*)(O + (size_t)(row0 + ai * HALF + m * 16) * HQK + col0 + bj * HALF) = w;
                    }
        }
    }
};
}

struct Args { const float* in[20]; float* out; unsigned char* ws; int ph_lo, ph_hi; };

__device__ __forceinline__ void p0_mod(const Args& a, LAS unsigned char* lds, float* mod, int tid, int wave, int lane) {
    LAS float* cact = (LAS float*)lds;
    LAS float* red = (LAS float*)(lds + 32768);
    const float* c = a.in[1];
    for (int i = tid; i < NB * DM; i += 512) { const float v = c[i]; cact[i] = v / (1.0f + __expf(-v)); }
    __syncthreads();
    const float* W = a.in[2]; const float* bias = a.in[3];
    const int cl = lane & 15, kr = lane >> 4;
    for (int slab = blockIdx.x; slab < NMODC / 64; slab += gridDim.x) {
        const int n0 = slab * 64;
        f32x4 acc0 = {0.f, 0.f, 0.f, 0.f}, acc1 = acc0, acc2 = acc0, acc3 = acc0;
        const float* wp = W + (size_t)(wave * 4 + kr) * NMODC + n0 + 4 * cl;
#pragma unroll 8
        for (int i = 0; i < 64; ++i) {
            const int k = i * 32 + wave * 4 + kr;
            const f32x4 wv = *(const f32x4*)(wp + (size_t)i * 32 * NMODC);
            acc0 += cact[k] * wv; acc1 += cact[DM + k] * wv; acc2 += cact[2 * DM + k] * wv; acc3 += cact[3 * DM + k] * wv;
        }
#pragma unroll
        for (int j = 0; j < 4; ++j) {
            acc0[j] += __shfl_xor(acc0[j], 16); acc0[j] += __shfl_xor(acc0[j], 32);
            acc1[j] += __shfl_xor(acc1[j], 16); acc1[j] += __shfl_xor(acc1[j], 32);
            acc2[j] += __shfl_xor(acc2[j], 16); acc2[j] += __shfl_xor(acc2[j], 32);
            acc3[j] += __shfl_xor(acc3[j], 16); acc3[j] += __shfl_xor(acc3[j], 32);
        }
        if (kr == 0) {
            *(LAS f32x4*)(red + (wave * 4 + 0) * 64 + 4 * cl) = acc0; *(LAS f32x4*)(red + (wave * 4 + 1) * 64 + 4 * cl) = acc1;
            *(LAS f32x4*)(red + (wave * 4 + 2) * 64 + 4 * cl) = acc2; *(LAS f32x4*)(red + (wave * 4 + 3) * 64 + 4 * cl) = acc3;
        }
        __syncthreads();
        if (tid < 256) {
            const int b = tid >> 6, col = tid & 63; float s = bias[n0 + col];
#pragma unroll
            for (int w = 0; w < 8; ++w) s += red[(w * 4 + b) * 64 + col];
            mod[(size_t)b * NMODC + n0 + col] = s;
        }
        __syncthreads();
    }
}

__device__ __forceinline__ void transpose_item(const float* W, int K, int N, bf16_t* WT, int mode, int item, int lane) {
    const int nblk = N >> 5, kb = item / nblk, nb = item - kb * nblk, k0 = kb * 64, n0 = nb * 32;
    const int lk = lane >> 3, ln = lane & 7;
    const float* src = W + (size_t)(k0 + 8 * lk) * N + n0 + 4 * ln;
    f32x4 v[8];
#pragma unroll
    for (int i = 0; i < 8; ++i) v[i] = *(const f32x4*)(src + (size_t)i * N);
    const int nn = n0 + 4 * ln;
    const int rowb = mode == 0 ? nn : ((nn >> 7) * 256 + (nn & 127) + (mode == 2 ? 128 : 0));
#pragma unroll
    for (int j = 0; j < 4; ++j) {
        u32x4 o; o.x = pk2(v[0][j], v[1][j]); o.y = pk2(v[2][j], v[3][j]); o.z = pk2(v[4][j], v[5][j]); o.w = pk2(v[6][j], v[7][j]);
        *(u32x4*)(WT + (size_t)(rowb + j) * K + k0 + 8 * lk) = o;
    }
}
__device__ __forceinline__ void p0_weights(const Args& a, unsigned char* ws, int gw, int ngw, int lane) {
    constexpr int I_GU = (DM / 64) * (DFF / 32), I_DN = (DFF / 64) * (DM / 32), I_IN = (DM / 64) * (INW / 32), I_OUT = (DM / 64) * (DM / 32), I_PW = (256 / 64) * (256 / 32);
    constexpr int NITEMS = 4 * I_GU + 2 * I_DN + I_IN + I_OUT + 4 * I_PW;
    for (int it = gw; it < NITEMS; it += ngw) {
        int r = it;
        if (r < I_GU) { transpose_item(a.in[5], DM, DFF, (bf16_t*)(ws + WS_WGU1), 1, r, lane); continue; } r -= I_GU;
        if (r < I_GU) { transpose_item(a.in[6], DM, DFF, (bf16_t*)(ws + WS_WGU1), 2, r, lane); continue; } r -= I_GU;
        if (r < I_DN) { transpose_item(a.in[7], DFF, DM, (bf16_t*)(ws + WS_WD1), 0, r, lane); continue; } r -= I_DN;
        if (r < I_IN) { transpose_item(a.in[9], DM, INW, (bf16_t*)(ws + WS_WIN), 0, r, lane); continue; } r -= I_IN;
        if (r < I_OUT) { transpose_item(a.in[14], DM, DM, (bf16_t*)(ws + WS_WOUT), 0, r, lane); continue; } r -= I_OUT;
        if (r < I_GU) { transpose_item(a.in[16], DM, DFF, (bf16_t*)(ws + WS_WGU2), 1, r, lane); continue; } r -= I_GU;
        if (r < I_GU) { transpose_item(a.in[17], DM, DFF, (bf16_t*)(ws + WS_WGU2), 2, r, lane); continue; } r -= I_GU;
        if (r < I_DN) { transpose_item(a.in[18], DFF, DM, (bf16_t*)(ws + WS_WD2), 0, r, lane); continue; } r -= I_DN;
        const int g = r / I_PW; r -= g * I_PW;
        transpose_item(a.in[10] + (size_t)g * 65536, 256, 256, (bf16_t*)(ws + WS_PWT) + (size_t)g * 65536, 0, r, lane);
    }
}

template <int MODE> __device__ __forceinline__ void norm_phase(const float* X, const float* w, const float* shift, const float* scale, bf16_t* H, float* outp, int gw, int ngw, int lane) {
    for (int row = gw; row < MT; row += ngw) {
        const f32x4* xr = (const f32x4*)(X + (size_t)row * DM) + lane;
        f32x4 v[8]; float ss = 0.f;
#pragma unroll
        for (int j = 0; j < 8; ++j) { v[j] = xr[64 * j]; ss += (v[j][0] * v[j][0] + v[j][1] * v[j][1]) + (v[j][2] * v[j][2] + v[j][3] * v[j][3]); }
        const float r = 1.0f / sqrtf(wave_sum(ss) * (1.0f / DM) + EPS);
        const int b = row >> 11;
#pragma unroll
        for (int j = 0; j < 8; ++j) {
            const int col = 4 * (lane + 64 * j);
            const f32x4 wv = *(const f32x4*)(w + col);
            f32x4 y = v[j] * r * wv;
            if (MODE == 0) {
                const f32x4 sc = *(const f32x4*)(scale + (size_t)b * NMODC + col), sh = *(const f32x4*)(shift + (size_t)b * NMODC + col);
                y = y * (1.0f + sc) + sh;
                u32x2 o; o.x = pk2(y[0], y[1]); o.y = pk2(y[2], y[3]);
                *(u32x2*)(H + (size_t)row * DM + col) = o;
            } else {
                *(f32x4*)(outp + (size_t)row * DM + col) = y;
            }
        }
    }
}

__device__ __forceinline__ void pool_unit(const bf16_t* ZP, const bf16_t* PWT, const float* pscale, bf16_t* MIX, LAS unsigned char* lds, int pu, int tid, int wave, int lane) {
    const int g = pu & 3, rt = pu >> 2, R0 = rt * 64, t0 = R0 & (SEQ - 1), w = 2 << g;
    constexpr int AST = 528;
    {
        const int c = tid & 255, sg = tid >> 8, ts = t0 + sg * 32;
        const bf16_t* up = ZP + (size_t)(R0 + sg * 32) * PW + g * 256 + c;
        float win = 0.f;
        for (int j = 1; j < w; ++j) if (ts - j >= 0) win += bf2f(up[-(ptrdiff_t)j * PW]);
#pragma unroll 4
        for (int i = 0; i < 32; ++i) {
            const int t = ts + i;
            const float cur = bf2f(up[(ptrdiff_t)i * PW]);
            win += cur;
            const float cnt = (float)(t + 1 < w ? t + 1 : w);
            const float pooled = win / cnt - cur;
            *(LAS bf16_t*)(lds + (sg * 32 + i) * AST + c * 2) = (bf16_t)(pk2(pooled, 0.f) & 0xffffu);
            if (t - w + 1 >= 0) win -= bf2f(up[(ptrdiff_t)(i - w + 1) * PW]);
        }
    }
    __syncthreads();
    const int fr = lane & 15, fq = lane >> 4;
    bf16x8 wf[2][8];
#pragma unroll
    for (int j = 0; j < 2; ++j)
#pragma unroll
        for (int ks = 0; ks < 8; ++ks) wf[j][ks] = *(const bf16x8*)(PWT + (size_t)g * 65536 + (size_t)(32 * wave + 16 * j + fr) * 256 + 32 * ks + 8 * fq);
#pragma unroll
    for (int tt = 0; tt < 4; ++tt) {
        f32x4 acc[2] = {{0.f, 0.f, 0.f, 0.f}, {0.f, 0.f, 0.f, 0.f}};
#pragma unroll
        for (int ks = 0; ks < 8; ++ks) {
            const bf16x8 bfrag = *(const LAS bf16x8*)(lds + (16 * tt + fr) * AST + (32 * ks + 8 * fq) * 2);
#pragma unroll
            for (int j = 0; j < 2; ++j) acc[j] = __builtin_amdgcn_mfma_f32_16x16x32_bf16(wf[j][ks], bfrag, acc[j], 0, 0, 0);
        }
#pragma unroll
        for (int j = 0; j < 2; ++j) {
            const int col = g * 256 + 32 * wave + 16 * j + 4 * fq;
            const f32x4 ps = *(const f32x4*)(pscale + col);
            const f32x4 y = acc[j] * ps;
            u32x2 o; o.x = pk2(y[0], y[1]); o.y = pk2(y[2], y[3]);
            *(u32x2*)(MIX + (size_t)(R0 + 16 * tt + fr) * DM + col) = o;
        }
    }
    __syncthreads();
}

struct HgrnT { const bf16_t *ZQ, *ZK, *ZV, *ZS; const float* ZG; float* ST; float* ADEC; const float* gnorm; bf16_t* MIX; };
template <int PASS> __device__ __forceinline__ void hgrn_unit(const HgrnT& T, LAS unsigned char* lds, int unit, int tid, int wave, int lane) {
    const int c = unit & 31, bh = unit >> 5, h = bh & 7, b = bh >> 3, R0 = b * SEQ + c * 64;
    if (PASS == 1 && c == 31) return;
    const int d = tid & 127, sg = tid >> 7, fr = lane & 15, fq = lane >> 4;
    constexpr int TS = 144, DS = 272;
    LAS float* SEG = (LAS float*)lds;
    LAS unsigned char* QT = lds + 2048;
    LAS unsigned char* KT = lds + 19456;
    LAS unsigned char* VT = lds + 36864;
    LAS unsigned char* SP = lds + 55296;
    LAS unsigned char* AT = lds + 90112;
    LAS float* SSQ = (LAS float*)(lds + 99328);
    const size_t base = (size_t)(R0 + sg * 16) * HQK + h * 128 + d;
    float bb[16];
#pragma unroll
    for (int i = 0; i < 16; ++i) bb[i] = T.ZG[base + (size_t)i * HQK];
    float run = 0.f;
#pragma unroll
    for (int i = 0; i < 16; ++i) { run += bb[i]; bb[i] = run; }
    SEG[sg * 128 + d] = run;
    __syncthreads();
    float pre = 0.f, tot = 0.f;
#pragma unroll
    for (int s = 0; s < 4; ++s) { const float v = SEG[s * 128 + d]; tot += v; if (s < sg) pre += v; }
#pragma unroll
    for (int i = 0; i < 16; ++i) bb[i] += pre;
    {
        unsigned pv[8];
#pragma unroll
        for (int i = 0; i < 8; ++i) pv[i] = (unsigned)T.ZV[base + (size_t)(2 * i) * HQK] | ((unsigned)T.ZV[base + (size_t)(2 * i + 1) * HQK] << 16);
        *(LAS u32x4*)(VT + d * TS + sg * 32) = (u32x4){pv[0], pv[1], pv[2], pv[3]};
        *(LAS u32x4*)(VT + d * TS + sg * 32 + 16) = (u32x4){pv[4], pv[5], pv[6], pv[7]};
    }
    if (PASS == 1) {
        if (sg == 0) T.ADEC[(size_t)unit * 128 + d] = __expf(tot);
        unsigned pkk[8];
#pragma unroll
        for (int i = 0; i < 8; ++i) {
            const float k0 = bf2f(T.ZK[base + (size_t)(2 * i) * HQK]) * __expf(tot - bb[2 * i]);
            const float k1 = bf2f(T.ZK[base + (size_t)(2 * i + 1) * HQK]) * __expf(tot - bb[2 * i + 1]);
            pkk[i] = pk2(k0, k1);
        }
        *(LAS u32x4*)(SP + d * TS + sg * 32) = (u32x4){pkk[0], pkk[1], pkk[2], pkk[3]};
        *(LAS u32x4*)(SP + d * TS + sg * 32 + 16) = (u32x4){pkk[4], pkk[5], pkk[6], pkk[7]};
        __syncthreads();
        bf16x8 bfr[2];
#pragma unroll
        for (int ks = 0; ks < 2; ++ks) bfr[ks] = *(const LAS bf16x8*)(VT + (16 * wave + fr) * TS + (32 * ks + 8 * fq) * 2);
        float* stp = T.ST + (size_t)unit * 16384 + (size_t)(16 * wave + fr) * 128 + 4 * fq;
#pragma unroll
        for (int dt = 0; dt < 8; ++dt) {
            f32x4 acc = {0.f, 0.f, 0.f, 0.f};
#pragma unroll
            for (int ks = 0; ks < 2; ++ks) {
                const bf16x8 afr = *(const LAS bf16x8*)(SP + (16 * dt + fr) * TS + (32 * ks + 8 * fq) * 2);
                acc = __builtin_amdgcn_mfma_f32_16x16x32_bf16(afr, bfr[ks], acc, 0, 0, 0);
            }
            *(f32x4*)(stp + 16 * dt) = acc;
        }
        __syncthreads();
    } else {
#pragma unroll
        for (int i = 0; i < 16; ++i) {
            const size_t o = base + (size_t)i * HQK;
            const float e = __expf(bb[i]);
            const float qt = bf2f(T.ZQ[o]) * e;
            const float kt = bf2f(T.ZK[o]) * __builtin_amdgcn_rcpf(e);
            *(LAS bf16_t*)(QT + (sg * 16 + i) * DS + d * 2) = (bf16_t)(pk2(qt, 0.f) & 0xffffu);
            *(LAS bf16_t*)(KT + (sg * 16 + i) * DS + d * 2) = (bf16_t)(pk2(kt, 0.f) & 0xffffu);
        }
        {
            const float* sp = T.ST + (size_t)unit * 16384;
#pragma unroll
            for (int j = 0; j < 8; ++j) {
                const int idx = tid + 512 * j, v = idx >> 5, d4 = idx & 31;
                const f32x4 s4 = *(const f32x4*)(sp + (size_t)idx * 4);
                u32x2 o; o.x = pk2(s4[0], s4[1]); o.y = pk2(s4[2], s4[3]);
                *(LAS u32x2*)(SP + v * DS + d4 * 8) = o;
            }
        }
        __syncthreads();
        {
            const int tt = wave >> 1;
#pragma unroll
            for (int jj = 0; jj < 2; ++jj) {
                const int st = (wave & 1) * 2 + jj;
                f32x4 acc = {0.f, 0.f, 0.f, 0.f};
                if (st <= tt) {
#pragma unroll
                    for (int ks = 0; ks < 4; ++ks) {
                        const bf16x8 afr = *(const LAS bf16x8*)(KT + (16 * st + fr) * DS + (32 * ks + 8 * fq) * 2);
                        const bf16x8 bfr = *(const LAS bf16x8*)(QT + (16 * tt + fr) * DS + (32 * ks + 8 * fq) * 2);
                        acc = __builtin_amdgcn_mfma_f32_16x16x32_bf16(afr, bfr, acc, 0, 0, 0);
                    }
                    const int t = 16 * tt + fr, s0 = 16 * st + 4 * fq;
#pragma unroll
                    for (int r = 0; r < 4; ++r) if (s0 + r > t) acc[r] = 0.f;
                }
                u32x2 o; o.x = pk2(acc[0], acc[1]); o.y = pk2(acc[2], acc[3]);
                *(LAS u32x2*)(AT + (16 * tt + fr) * TS + (16 * st + 4 * fq) * 2) = o;
            }
        }
        __syncthreads();
        {
            const int tt = wave >> 1, t = 16 * tt + fr;
            f32x4 o4[4]; float ssq = 0.f;
            bf16x8 ba[2], bq[4];
#pragma unroll
            for (int ks = 0; ks < 2; ++ks) ba[ks] = *(const LAS bf16x8*)(AT + t * TS + (32 * ks + 8 * fq) * 2);
#pragma unroll
            for (int ks = 0; ks < 4; ++ks) bq[ks] = *(const LAS bf16x8*)(QT + t * DS + (32 * ks + 8 * fq) * 2);
#pragma unroll
            for (int jj = 0; jj < 4; ++jj) {
                const int vt = (wave & 1) * 4 + jj;
                f32x4 acc = {0.f, 0.f, 0.f, 0.f};
#pragma unroll
                for (int ks = 0; ks < 2; ++ks) acc = __builtin_amdgcn_mfma_f32_16x16x32_bf16(*(const LAS bf16x8*)(VT + (16 * vt + fr) * TS + (32 * ks + 8 * fq) * 2), ba[ks], acc, 0, 0, 0);
#pragma unroll
                for (int ks = 0; ks < 4; ++ks) acc = __builtin_amdgcn_mfma_f32_16x16x32_bf16(*(const LAS bf16x8*)(SP + (16 * vt + fr) * DS + (32 * ks + 8 * fq) * 2), bq[ks], acc, 0, 0, 0);
                o4[jj] = acc;
                ssq += (acc[0] * acc[0] + acc[1] * acc[1]) + (acc[2] * acc[2] + acc[3] * acc[3]);
            }
            ssq += __shfl_xor(ssq, 16); ssq += __shfl_xor(ssq, 32);
            if (fq == 0) SSQ[(wave & 1) * 64 + t] = ssq;
            __syncthreads();
            const float rinv = 1.0f / sqrtf((SSQ[t] + SSQ[64 + t]) * (1.0f / 128.0f) + EPS);
#pragma unroll
            for (int jj = 0; jj < 4; ++jj) {
                const int v0 = 16 * ((wave & 1) * 4 + jj) + 4 * fq;
                const f32x4 gw = *(const f32x4*)(T.gnorm + v0);
                const u32x2 zs = *(const u32x2*)(T.ZS + (size_t)(R0 + t) * HQK + h * 128 + v0);
                const f32x4 y = o4[jj] * rinv * gw * (f32x4){bf2f(zs.x & 0xffffu), bf2f(zs.x >> 16), bf2f(zs.y & 0xffffu), bf2f(zs.y >> 16)};
                u32x2 o; o.x = pk2(y[0], y[1]); o.y = pk2(y[2], y[3]);
                *(u32x2*)(T.MIX + (size_t)(R0 + t) * DM + PW + h * 128 + v0) = o;
            }
        }
        __syncthreads();
    }
}

__device__ __forceinline__ void scan_phase(float* ST, const float* ADEC, int tid) {
    for (int e = blockIdx.x * 512 + tid; e < 32 * 4096; e += gridDim.x * 512) {
        const int bh = e >> 12, within = e & 4095, d4 = within & 31;
        float* st = ST + (size_t)bh * 32 * 16384 + (size_t)within * 4;
        const float* ad = ADEC + (size_t)bh * 32 * 128 + d4 * 4;
        f32x4 S = {0.f, 0.f, 0.f, 0.f};
        for (int cb = 0; cb < 4; ++cb) {
            f32x4 L[8], A[8];
#pragma unroll
            for (int j = 0; j < 8; ++j) { L[j] = *(const f32x4*)(st + (size_t)(cb * 8 + j) * 16384); A[j] = *(const f32x4*)(ad + (cb * 8 + j) * 128); }
#pragma unroll
            for (int j = 0; j < 8; ++j) { *(f32x4*)(st + (size_t)(cb * 8 + j) * 16384) = S; S = A[j] * S + L[j]; }
        }
    }
}

__global__ void __launch_bounds__(512, 2) fwd_megakernel(Args a) {
    extern __shared__ __attribute__((aligned(16))) unsigned char lds_raw[];
    LAS unsigned char* lds = (LAS unsigned char*)lds_raw;
    cg::grid_group grid = cg::this_grid();
    const int tid = threadIdx.x, lane = tid & 63, wave = __builtin_amdgcn_readfirstlane(tid >> 6);
    const int G = gridDim.x, gw = blockIdx.x * 8 + wave, ngw = G * 8;
    unsigned char* ws = a.ws;
    float* mod = (float*)(ws + WS_MOD); float* lbv = (float*)(ws + WS_LB);
    bf16_t* H = (bf16_t*)(ws + WS_H); float* X = (float*)(ws + WS_X); bf16_t* MIX = (bf16_t*)(ws + WS_MIX); bf16_t* HID = (bf16_t*)(ws + WS_HID);

    const int lo = a.ph_lo, hi = a.ph_hi;
#define IN(k) (lo <= (k) && (k) < hi)
#define SEAM(k) do { if ((k) + 1 < hi) grid.sync(); } while (0)
    if (IN(PH_PRO)) {
#ifndef SKIP_PRO
        p0_mod(a, lds, mod, tid, wave, lane);
        if (blockIdx.x == 0) {
            const float* l = a.in[12];
            for (int j = tid; j < HQK; j += 512) {
                const float l0 = l[j], l1 = l[HQK + j], m = fmaxf(l0, l1), e0 = __expf(l0 - m), e1 = __expf(l1 - m), s = e0 + e1, p0 = e0 / s, p1 = e1 / s;
                lbv[j] = (p0 + p1) - p0;
            }
        }
        p0_weights(a, ws, gw, ngw, lane);
#endif
        SEAM(PH_PRO);
    }
    if (IN(PH_N1)) { norm_phase<0>(a.in[0], a.in[4], mod + 0 * DM, mod + 1 * DM, H, nullptr, gw, ngw, lane); SEAM(PH_N1); }
    if (IN(PH_GU1)) {
#ifndef SKIP_GU
        pg8::Gemm g{H, (const bf16_t*)(ws + WS_WGU1), MT, 2 * DFF, DM};
        pg8::StaticOrder S; S.init(MT, 2 * DFF, G, (int)blockIdx.x);
        pg8::EpiSwiglu E{HID, DFF};
        pg8::gemm_phase<pg8::EpiSwiglu, pg8::StaticOrder, true, true>(lds, g, S, E);
#endif
        SEAM(PH_GU1);
    }
    if (IN(PH_DN1)) {
#ifndef SKIP_DN
        pg8::Gemm g{HID, (const bf16_t*)(ws + WS_WD1), MT, DM, DFF};
        pg8::StaticOrder S; S.init(MT, DM, G, (int)blockIdx.x);
        pg8::EpiResid E{a.in[0], X, mod + 2 * DM, 0.5f};
        pg8::gemm_phase<pg8::EpiResid, pg8::StaticOrder, true, true>(lds, g, S, E);
#endif
        SEAM(PH_DN1);
    }
    if (IN(PH_N2)) { norm_phase<0>(X, a.in[8], mod + 3 * DM, mod + 4 * DM, H, nullptr, gw, ngw, lane); SEAM(PH_N2); }
    if (IN(PH_WIN)) {
#ifndef SKIP_WIN
        pg8::Gemm g{H, (const bf16_t*)(ws + WS_WIN), MT, INW, DM};
        pg8::StaticOrder S; S.init(MT, INW, G, (int)blockIdx.x);
        pg8::EpiWin E{(bf16_t*)(ws + WS_ZP), (bf16_t*)(ws + WS_ZQ), (bf16_t*)(ws + WS_ZK), (bf16_t*)(ws + WS_ZV), (bf16_t*)(ws + WS_ZS), (float*)(ws + WS_ZG), lbv};
        pg8::gemm_phase<pg8::EpiWin, pg8::StaticOrder, true, true>(lds, g, S, E);
#endif
        SEAM(PH_WIN);
    }
#ifndef SKIP_MIX
    if (IN(PH_MIXA)) {
        HgrnT T{(const bf16_t*)(ws + WS_ZQ), (const bf16_t*)(ws + WS_ZK), (const bf16_t*)(ws + WS_ZV), (const bf16_t*)(ws + WS_ZS), (const float*)(ws + WS_ZG),
                (float*)(ws + WS_ST), (float*)(ws + WS_ADEC), a.in[13], MIX};
        for (int it = blockIdx.x; it < 1024 + 512; it += G) {
            if (it < 1024) hgrn_unit<1>(T, lds, it, tid, wave, lane);
            else pool_unit((const bf16_t*)(ws + WS_ZP), (const bf16_t*)(ws + WS_PWT), a.in[11], MIX, lds, it - 1024, tid, wave, lane);
        }
        SEAM(PH_MIXA);
    }
    if (IN(PH_SCAN)) { scan_phase((float*)(ws + WS_ST), (const float*)(ws + WS_ADEC), tid); SEAM(PH_SCAN); }
    if (IN(PH_MIXB)) {
        HgrnT T{(const bf16_t*)(ws + WS_ZQ), (const bf16_t*)(ws + WS_ZK), (const bf16_t*)(ws + WS_ZV), (const bf16_t*)(ws + WS_ZS), (const float*)(ws + WS_ZG),
                (float*)(ws + WS_ST), (float*)(ws + WS_ADEC), a.in[13], MIX};
        for (int it = blockIdx.x; it < 1024; it += G) hgrn_unit<3>(T, lds, it, tid, wave, lane);
        SEAM(PH_MIXB);
    }
#endif
    if (IN(PH_WOUT)) {
#ifndef SKIP_DN
        pg8::Gemm g{MIX, (const bf16_t*)(ws + WS_WOUT), MT, DM, DM};
        pg8::StaticOrder S; S.init(MT, DM, G, (int)blockIdx.x);
        pg8::EpiResid E{X, X, mod + 5 * DM, 1.0f};
        pg8::gemm_phase<pg8::EpiResid, pg8::StaticOrder, true, true>(lds, g, S, E);
#endif
        SEAM(PH_WOUT);
    }
    if (IN(PH_N3)) { norm_phase<0>(X, a.in[15], mod + 6 * DM, mod + 7 * DM, H, nullptr, gw, ngw, lane); SEAM(PH_N3); }
    if (IN(PH_GU2)) {
#ifndef SKIP_GU
        pg8::Gemm g{H, (const bf16_t*)(ws + WS_WGU2), MT, 2 * DFF, DM};
        pg8::StaticOrder S; S.init(MT, 2 * DFF, G, (int)blockIdx.x);
        pg8::EpiSwiglu E{HID, DFF};
        pg8::gemm_phase<pg8::EpiSwiglu, pg8::StaticOrder, true, true>(lds, g, S, E);
#endif
        SEAM(PH_GU2);
    }
    if (IN(PH_DN2)) {
#ifndef SKIP_DN
        pg8::Gemm g{HID, (const bf16_t*)(ws + WS_WD2), MT, DM, DFF};
        pg8::StaticOrder S; S.init(MT, DM, G, (int)blockIdx.x);
        pg8::EpiResid E{X, X, mod + 8 * DM, 0.5f};
        pg8::gemm_phase<pg8::EpiResid, pg8::StaticOrder, true, true>(lds, g, S, E);
#endif
        SEAM(PH_DN2);
    }
    if (IN(PH_FIN)) norm_phase<1>(X, a.in[19], nullptr, nullptr, nullptr, a.out, gw, ngw, lane);
#undef IN
#undef SEAM
}

extern "C" void kernel_launch(void* const* d_in, const int* in_sizes, int n_in, void* d_out, int out_size, void* d_ws, size_t ws_size, hipStream_t stream) {
    static int grid = 0;
    if (grid == 0) {
        if (n_in != 20 || in_sizes[0] != MT * DM || out_size != MT * DM || ws_size < WS_END) {
            fprintf(stderr, "kernel_launch: unexpected problem (n_in %d, in0 %d, out %d, ws %zu); nothing launched\n", n_in, n_in > 0 ? in_sizes[0] : -1, out_size, ws_size); grid = -1; return; }
        int dev = 0, cus = 0, per_cu = 0;
        if (hipGetDevice(&dev) != hipSuccess || hipDeviceGetAttribute(&cus, hipDeviceAttributeMultiprocessorCount, dev) != hipSuccess) { grid = -1; return; }
        if (hipFuncSetAttribute((const void*)fwd_megakernel, hipFuncAttributeMaxDynamicSharedMemorySize, LDS_BYTES) != hipSuccess) { fprintf(stderr, "kernel_launch: hipFuncSetAttribute failed\n"); grid = -1; return; }
        if (hipOccupancyMaxActiveBlocksPerMultiprocessor(&per_cu, (const void*)fwd_megakernel, 512, LDS_BYTES) != hipSuccess || per_cu < 1) { fprintf(stderr, "kernel_launch: occupancy query failed (%d)\n", per_cu); (void)hipGetLastError(); grid = -1; return; }
        grid = cus * per_cu;
    }
    if (grid < 0) return;
    Args a{};
    for (int i = 0; i < 20; ++i) a.in[i] = (const float*)d_in[i];
    a.out = (float*)d_out; a.ws = (unsigned char*)d_ws;
    for (int li = 0; li < MK_N_LAUNCHES; ++li) {
        a.ph_lo = (MK_N_LAUNCHES == 1) ? 0 : li; a.ph_hi = (MK_N_LAUNCHES == 1) ? NPH : li + 1;
        void* args[] = {&a};
        const hipError_t e = hipLaunchCooperativeKernel((const void*)fwd_megakernel, dim3(grid), dim3(512), args, LDS_BYTES, stream);
        if (e != hipSuccess) { fprintf(stderr, "kernel_launch: cooperative launch failed: %s (grid %d)\n", hipGetErrorString(e), grid); break; }
    }
}
```

```cpp
#include <hip/hip_runtime.h>
#include <hip/hip_cooperative_groups.h>
#include <cstdio>
#include <cstdint>
namespace cg = cooperative_groups;
namespace pg8 {
#define PG8_LAS __attribute__((address_space(3)))
typedef unsigned short bf16_t;
typedef short bf16x8 __attribute__((ext_vector_type(8)));
typedef float f32x4 __attribute__((ext_vector_type(4)));
typedef unsigned u32x4 __attribute__((ext_vector_type(4)));
constexpr int BM = 256, BK = 64, HALF = 128, HTB = HALF * BK * 2  , STAGE_BYTES = 8 * HTB, NXCD = 8, WGM = 8;

__host__ __device__ __forceinline__ int lds_byte(int r, int c) { const int st = (r >> 4) * 2 + (c >> 5), rr = r & 15, cc = c & 31, ob = rr * 64 + cc * 2; return st * 1024 + (ob ^ (((ob >> 9) & 1) << 5)); }
__host__ __device__ __forceinline__ void stage_rc(int b, int& R, int& C) { const int st = b / 1024, sb = b % 1024, swz = sb ^ (((sb >> 9) & 1) << 5); R = (st >> 1) * 16 + swz / 64; C = (st & 1) * 32 + (swz % 64) / 2; }
__host__ __device__ __forceinline__ int perm32(int rho) { const int n = rho >> 4, i = rho & 15; return 8 * (i >> 2) + 4 * n + (i & 3); }

struct Unit { int pm, pn; };
struct Gemm { const bf16_t* A; const bf16_t* Bt; int M, N, K; };

struct StaticOrder {
    int nM, nN, nwg, G, c;
    __host__ __device__ void init(int M, int N, int G_, int c_) { nM = M / BM; nN = N / BM; nwg = nM * nN; G = G_; c = c_; }
    __host__ __device__ bool next(int i, Unit& u) const {
        const long L = (long)i * G + c; if (L >= nwg) return false;
        int wgid = (int)L; { const int q = nwg / NXCD, r = nwg % NXCD, xcd = wgid % NXCD, off = wgid / NXCD; wgid = (xcd < r ? xcd * (q + 1) : r * (q + 1) + (xcd - r) * q) + off; }
        const int nig = WGM * nN, gid = wgid / nig, fm = gid * WGM, gsz = (nM - fm) < WGM ? (nM - fm) : WGM;
        u.pm = fm + ((wgid % nig) % gsz); u.pn = (wgid % nig) / gsz; return true;
    }
    __device__ __forceinline__ void a_ready(const Unit&) const {}
    __device__ __forceinline__ void done(const Unit&) const {}
};

__device__ __forceinline__ unsigned cvt_pk_bf16(float lo, float hi) { unsigned r; asm volatile("v_cvt_pk_bf16_f32 %0, %1, %2" : "=v"(r) : "v"(lo), "v"(hi)); return r; }
typedef float f32x2 __attribute__((ext_vector_type(2)));
template <class Epi, class Sched, bool ALIGN_EPI = false, bool SP2 = false>
__device__ __forceinline__ void gemm_phase(PG8_LAS unsigned char* lds, const Gemm g, const Sched& S, const Epi& E) {
    const int tid = threadIdx.x, wid = __builtin_amdgcn_readfirstlane(tid >> 6), lane = tid & 63, wr = wid >> 2, wc = wid & 3, fr = lane & 15, fq = lane >> 4;
    const int K = g.K, nt = K / BK;
    unsigned voffA[2], voffB[2];
#pragma unroll
    for (int i = 0; i < 2; ++i) { int R, C; stage_rc(tid * 16 + i * 8192, R, C); const int Rb = Epi::PERM ? ((R & ~31) + perm32(R & 31)) : R;
        voffA[i] = (unsigned)(R * K + C) * 2u; voffB[i] = (unsigned)(Rb * K + C) * 2u; }
    const size_t kstep = (size_t)(BK * 2);
    const size_t hstep = (size_t)HALF * K * 2;
    const size_t tstep = 2 * hstep;
    const unsigned ldsw = (unsigned)wid * 1024u;
    const int aoff = lds_byte(wr * 64 + fr, fq * 8), boff = lds_byte(wc * 32 + fr, fq * 8);
#define PG8_SA(b, h) (((b) * 2 + (h)) * HTB)
#define PG8_SB(b, h) ((4 + (b) * 2 + (h)) * HTB)
#define PG8_STAGE(bufoff, gbase, voff) do { _Pragma("unroll") for (int _i = 0; _i < 2; ++_i) \
        __builtin_amdgcn_global_load_lds((const unsigned*)((const char*)(gbase) + (voff)[_i]), (PG8_LAS unsigned*)(lds + (bufoff) + ldsw + _i * 8192), 16, 0, 0); } while (0)
#define PG8_LDA(dst, b, h) do { _Pragma("unroll") for (int m = 0; m < 4; ++m) _Pragma("unroll") for (int k = 0; k < 2; ++k) dst[m][k] = *(const PG8_LAS bf16x8*)(lds + PG8_SA(b, h) + aoff + m * 2048 + k * 1024); } while (0)
#define PG8_LDB(dst, b, h) do { _Pragma("unroll") for (int n = 0; n < 2; ++n) _Pragma("unroll") for (int k = 0; k < 2; ++k) dst[n][k] = *(const PG8_LAS bf16x8*)(lds + PG8_SB(b, h) + boff + n * 2048 + k * 1024); } while (0)
#define PG8_MMA(ai, bj, At, Bt) do { __builtin_amdgcn_s_setprio(1); _Pragma("unroll") for (int m = 0; m < 4; ++m) _Pragma("unroll") for (int n = 0; n < 2; ++n) _Pragma("unroll") for (int k = 0; k < 2; ++k) \
        acc[ai][bj][m][n] = __builtin_amdgcn_mfma_f32_16x16x32_bf16(Bt[n][k], At[m][k], acc[ai][bj][m][n], 0, 0, 0); __builtin_amdgcn_s_setprio(0); } while (0)
#define PG8_WAIT_V(n) asm volatile("s_waitcnt vmcnt(" #n ")" ::: "memory")
#define PG8_WAIT_L(n) asm volatile("s_waitcnt lgkmcnt(" #n ")" ::: "memory")
#define PG8_BAR __builtin_amdgcn_s_barrier()
#define PG8_SCHED __builtin_amdgcn_sched_barrier(0)
    Unit cur, nxt; int ui = 0;
    if (!S.next(0, cur)) return;
    f32x4 acc[2][2][4][2];
#pragma unroll
    for (int a = 0; a < 2; ++a)
#pragma unroll
        for (int b = 0; b < 2; ++b)
#pragma unroll
            for (int m = 0; m < 4; ++m)
#pragma unroll
                for (int n = 0; n < 2; ++n) acc[a][b][m][n] = (f32x4){0.f, 0.f, 0.f, 0.f};
    bf16x8 At[4][2], B0[2][2], B1[2][2];
    const char* cA = (const char*)g.A + (size_t)cur.pm * tstep; const char* cB = (const char*)g.Bt + (size_t)cur.pn * tstep;
    S.a_ready(cur);
    if constexpr (SP2) {
        PG8_STAGE(PG8_SB(0, 0), cB, voffB); PG8_STAGE(PG8_SB(0, 1), cB + hstep, voffB); PG8_STAGE(PG8_SA(0, 0), cA, voffA); PG8_STAGE(PG8_SA(0, 1), cA + hstep, voffA);
        if (wr == 1) PG8_BAR;
        PG8_WAIT_V(2); PG8_BAR;
        PG8_STAGE(PG8_SB(1, 0), cB + kstep, voffB); PG8_STAGE(PG8_SA(1, 0), cA + kstep, voffA); PG8_STAGE(PG8_SB(1, 1), cB + hstep + kstep, voffB);
        PG8_WAIT_V(6); PG8_BAR;
    } else {
        PG8_STAGE(PG8_SB(0, 0), cB, voffB); PG8_STAGE(PG8_SA(0, 0), cA, voffA); PG8_STAGE(PG8_SB(0, 1), cB + hstep, voffB); PG8_STAGE(PG8_SA(0, 1), cA + hstep, voffA);
        if (wr == 1) PG8_BAR;
        PG8_WAIT_V(4); PG8_BAR;
        PG8_STAGE(PG8_SB(1, 0), cB + kstep, voffB); PG8_STAGE(PG8_SA(1, 0), cA + kstep, voffA); PG8_STAGE(PG8_SB(1, 1), cB + hstep + kstep, voffB);
        PG8_WAIT_V(6); PG8_BAR;
    }
    for (;;) {
        const bool has_next = S.next(ui + 1, nxt);
        const char* nA = has_next ? (const char*)g.A + (size_t)nxt.pm * tstep : cA; const char* nB = has_next ? (const char*)g.Bt + (size_t)nxt.pn * tstep : cB;
        for (int t = 0; t < nt; t += 2) {
            const bool last = (t == nt - 2);
            const char* a1 = cA + (size_t)(t + 1) * kstep;
            const char* a2 = last ? nA : cA + (size_t)(t + 2) * kstep; const char* b2 = last ? nB : cB + (size_t)(t + 2) * kstep;
            const char* a3 = a2 + kstep; const char* b3 = b2 + kstep;
            if (last && has_next) S.a_ready(nxt);
            if constexpr (SP2) {
            PG8_LDB(B0, 0, 0); PG8_LDB(B1, 0, 1); PG8_SCHED; PG8_LDA(At, 0, 0); PG8_STAGE(PG8_SA(1, 1), a1 + hstep, voffA);
            PG8_WAIT_V(8); PG8_WAIT_L(0); PG8_BAR; PG8_MMA(0, 0, At, B0); PG8_MMA(0, 1, At, B1); PG8_BAR; PG8_SCHED;
            PG8_LDA(At, 0, 1); PG8_STAGE(PG8_SB(0, 0), b2, voffB); PG8_STAGE(PG8_SB(0, 1), b2 + hstep, voffB); PG8_STAGE(PG8_SA(0, 0), a2, voffA);
            PG8_WAIT_V(8); PG8_WAIT_L(0); PG8_BAR; PG8_MMA(1, 0, At, B0); PG8_MMA(1, 1, At, B1); PG8_BAR; PG8_SCHED;
            PG8_LDB(B0, 1, 0); PG8_LDB(B1, 1, 1); PG8_SCHED; PG8_LDA(At, 1, 0); PG8_STAGE(PG8_SA(0, 1), a2 + hstep, voffA);
            PG8_WAIT_V(8); PG8_WAIT_L(0); PG8_BAR; PG8_MMA(0, 0, At, B0); PG8_MMA(0, 1, At, B1); PG8_BAR; PG8_SCHED;
            PG8_LDA(At, 1, 1); PG8_STAGE(PG8_SB(1, 0), b3, voffB); PG8_STAGE(PG8_SB(1, 1), b3 + hstep, voffB); PG8_STAGE(PG8_SA(1, 0), a3, voffA);
            PG8_WAIT_V(8); PG8_WAIT_L(0); PG8_BAR; PG8_MMA(1, 0, At, B0); PG8_MMA(1, 1, At, B1); PG8_BAR; PG8_SCHED;
            } else {
            PG8_LDB(B0, 0, 0); PG8_SCHED; PG8_LDA(At, 0, 0); PG8_STAGE(PG8_SA(1, 1), a1 + hstep, voffA);
            PG8_WAIT_L(8); PG8_BAR; PG8_WAIT_L(0); PG8_MMA(0, 0, At, B0); PG8_BAR; PG8_SCHED;
            PG8_LDB(B1, 0, 1); PG8_STAGE(PG8_SB(0, 0), b2, voffB);
            PG8_BAR; PG8_WAIT_L(0); PG8_MMA(0, 1, At, B1); PG8_BAR;
            PG8_LDA(At, 0, 1); PG8_STAGE(PG8_SA(0, 0), a2, voffA);
            PG8_BAR; PG8_WAIT_L(0); PG8_MMA(1, 0, At, B0); PG8_BAR; PG8_SCHED;
            PG8_STAGE(PG8_SB(0, 1), b2 + hstep, voffB);
            PG8_WAIT_V(6); PG8_BAR; PG8_MMA(1, 1, At, B1); PG8_BAR;
            PG8_LDB(B0, 1, 0); PG8_SCHED; PG8_LDA(At, 1, 0); PG8_STAGE(PG8_SA(0, 1), a2 + hstep, voffA);
            PG8_WAIT_L(8); PG8_BAR; PG8_WAIT_L(0); PG8_MMA(0, 0, At, B0); PG8_BAR; PG8_SCHED;
            PG8_LDB(B1, 1, 1); PG8_STAGE(PG8_SB(1, 0), b3, voffB);
            PG8_BAR; PG8_WAIT_L(0); PG8_MMA(0, 1, At, B1); PG8_BAR;
            PG8_LDA(At, 1, 1); PG8_STAGE(PG8_SA(1, 0), a3, voffA);
            PG8_BAR; PG8_WAIT_L(0); PG8_MMA(1, 0, At, B0); PG8_BAR; PG8_SCHED;
            PG8_STAGE(PG8_SB(1, 1), b3 + hstep, voffB);
            PG8_WAIT_V(6); PG8_BAR; PG8_MMA(1, 1, At, B1); PG8_BAR;
            }
        }
        if constexpr (ALIGN_EPI) { if (wr == 0) PG8_BAR; }
        if constexpr (!Epi::AFTER_DRAIN) { E(acc, cur, wr, wc, fr, fq); S.done(cur); }
        if (!has_next) break;
#pragma unroll
        for (int a = 0; a < 2; ++a)
#pragma unroll
            for (int b = 0; b < 2; ++b)
#pragma unroll
                for (int m = 0; m < 4; ++m)
#pragma unroll
                    for (int n = 0; n < 2; ++n) acc[a][b][m][n] = (f32x4){0.f, 0.f, 0.f, 0.f};
        cur = nxt; cA = nA; cB = nB; ++ui;
        if constexpr (ALIGN_EPI) { if (wr == 1) PG8_BAR; }
    }
    PG8_WAIT_V(0);
    if constexpr (!ALIGN_EPI) { if (wr == 0) PG8_BAR; }
    PG8_BAR;
    if constexpr (Epi::AFTER_DRAIN) { E.fused(acc, cur, wr, wc, fr, fq, lds, wid, lane); S.done(cur); }
#undef PG8_SA
#undef PG8_SB
#undef PG8_STAGE
#undef PG8_LDA
#undef PG8_LDB
#undef PG8_MMA
#undef PG8_WAIT_V
#undef PG8_WAIT_L
#undef PG8_BAR
#undef PG8_SCHED
}
}

#ifndef REP_PRO
#define REP_PRO 1
#endif
#ifndef REP_N1
#define REP_N1 1
#endif
#ifndef REP_GU1
#define REP_GU1 1
#endif
#ifndef REP_DN1
#define REP_DN1 1
#endif
#ifndef REP_WIN
#define REP_WIN 1
#endif
#ifndef REP_MIXA
#define REP_MIXA 1
#endif
#ifndef REP_MIXB
#define REP_MIXB 1
#endif
#ifndef MK_N_LAUNCHES
#define MK_N_LAUNCHES 1
#endif

constexpr int NB = 4, SEQ = 2048, DM = 2048, MT = NB * SEQ;
constexpr int DFF = 5632, NMODC = 9 * DM;
constexpr int PW = 1024, HQK = 1024, INW = 5120;
constexpr float EPS = 1e-6f;
constexpr int NPH = 14;
enum { PH_PRO = 0, PH_N1, PH_GU1, PH_DN1, PH_N2, PH_WIN, PH_MIXA, PH_SCAN, PH_MIXB, PH_WOUT, PH_N3, PH_GU2, PH_DN2, PH_FIN };

constexpr size_t MiB = 1u << 20;
constexpr size_t WS_MOD = 0, WS_LB = MiB / 2, WS_BAR = 3 * MiB / 4  , WS_ADEC = 1 * MiB, WS_PWT = 3 * MiB / 2;
constexpr size_t WS_WGU1 = 2 * MiB, WS_WD1 = 46 * MiB, WS_WIN = 68 * MiB, WS_WOUT = 88 * MiB, WS_WGU2 = 96 * MiB, WS_WD2 = 140 * MiB;
constexpr size_t WS_H = 162 * MiB, WS_X = 194 * MiB, WS_MIX = 258 * MiB, WS_HID = 290 * MiB, WS_ST = 290 * MiB  ;
constexpr size_t WS_ZP = 378 * MiB, WS_ZQ = 394 * MiB, WS_ZK = 410 * MiB, WS_ZV = 426 * MiB, WS_ZS = 442 * MiB, WS_ZG = 458 * MiB, WS_END = 490 * MiB;
constexpr int LDS_BYTES = 143360;
constexpr int LDS_MISC = 139264;

#define LAS __attribute__((address_space(3)))
typedef unsigned short bf16_t;
typedef float f32x4 __attribute__((ext_vector_type(4)));
typedef unsigned u32x4 __attribute__((ext_vector_type(4)));
typedef unsigned u32x2 __attribute__((ext_vector_type(2)));
typedef short bf16x8 __attribute__((ext_vector_type(8)));

__device__ __forceinline__ float bf2f(unsigned h) { return __uint_as_float(h << 16); }
__device__ __forceinline__ unsigned pk2(float lo, float hi) { return pg8::cvt_pk_bf16(lo, hi); }
__device__ __forceinline__ float silu_f(float x) { return x * __builtin_amdgcn_rcpf(1.0f + __expf(-x)); }
__device__ __forceinline__ float wave_sum(float v) {
#pragma unroll
    for (int o = 1; o < 64; o <<= 1) v += __shfl_xor(v, o);
    return v;
}

namespace pg8 {
struct EpiSwiglu {
    static constexpr bool PERM = true, AFTER_DRAIN = false;
    bf16_t* O; int ldc;
    __device__ __forceinline__ void operator()(const f32x4 (&acc)[2][2][4][2], const Unit& u, int wr, int wc, int fr, int fq) const {
        const int row0 = u.pm * BM + wr * 64 + fr, col0 = u.pn * HALF + wc * 32 + 8 * fq;
#pragma unroll
        for (int ai = 0; ai < 2; ++ai)
#pragma unroll
            for (int m = 0; m < 4; ++m) {
                bf16_t* rowp = O + (size_t)(row0 + ai * HALF + m * 16) * ldc + col0;
                const f32x4 g0 = acc[ai][0][m][0], g1 = acc[ai][0][m][1], u0 = acc[ai][1][m][0], u1 = acc[ai][1][m][1];
                u32x4 w;
                w.x = cvt_pk_bf16(silu_f(g0[0]) * u0[0], silu_f(g0[1]) * u0[1]); w.y = cvt_pk_bf16(silu_f(g0[2]) * u0[2], silu_f(g0[3]) * u0[3]);
                w.z = cvt_pk_bf16(silu_f(g1[0]) * u1[0], silu_f(g1[1]) * u1[1]); w.w = cvt_pk_bf16(silu_f(g1[2]) * u1[2], silu_f(g1[3]) * u1[3]);
                *(u32x4*)rowp = w;
            }
    }
};
struct EpiResid {
    static constexpr bool PERM = true, AFTER_DRAIN = false;
    const float* Xin; float* Xout; const float* gate; float coef;
    __device__ __forceinline__ void operator()(const f32x4 (&acc)[2][2][4][2], const Unit& u, int wr, int wc, int fr, int fq) const {
        const int row0 = u.pm * BM + wr * 64 + fr, col0 = u.pn * BM + wc * 32 + 8 * fq;
        const float* gp = gate + (size_t)(u.pm >> 3) * NMODC + col0;
        f32x4 gv[2][2];
#pragma unroll
        for (int bj = 0; bj < 2; ++bj)
#pragma unroll
            for (int n = 0; n < 2; ++n) gv[bj][n] = *(const f32x4*)(gp + bj * HALF + 4 * n) * coef;
#pragma unroll
        for (int ai = 0; ai < 2; ++ai)
#pragma unroll
            for (int m = 0; m < 4; ++m) {
                const size_t off = (size_t)(row0 + ai * HALF + m * 16) * DM + col0;
#pragma unroll
                for (int bj = 0; bj < 2; ++bj)
#pragma unroll
                    for (int n = 0; n < 2; ++n) {
                        const f32x4 xi = *(const f32x4*)(Xin + off + bj * HALF + 4 * n);
                        *(f32x4*)(Xout + off + bj * HALF + 4 * n) = xi + gv[bj][n] * acc[ai][bj][m][n];
                    }
                asm volatile("" ::: "memory");
            }
    }
};
struct EpiWin {
    static constexpr bool PERM = true, AFTER_DRAIN = false;
    bf16_t *ZP, *ZQ, *ZK, *ZV, *ZS; float* ZG; const float* lb;
    __device__ __forceinline__ void operator()(const f32x4 (&acc)[2][2][4][2], const Unit& u, int wr, int wc, int fr, int fq) const {
        const int seg = u.pn >> 2;
        const int row0 = u.pm * BM + wr * 64 + fr, col0 = (u.pn & 3) * BM + wc * 32 + 8 * fq;
        bf16_t* O = seg == 0 ? ZP : seg == 1 ? ZQ : seg == 2 ? ZK : seg == 3 ? ZV : ZS;
        if (seg == 2) {
#pragma unroll
            for (int bj = 0; bj < 2; ++bj) {
                const f32x4 l0 = *(const f32x4*)(lb + col0 + bj * HALF), l1 = *(const f32x4*)(lb + col0 + bj * HALF + 4);
#pragma unroll
                for (int ai = 0; ai < 2; ++ai)
#pragma unroll
                    for (int m = 0; m < 4; ++m) {
                        const size_t off = (size_t)(row0 + ai * HALF + m * 16) * HQK + col0 + bj * HALF;
                        float kk[8], gg[8];
#pragma unroll
                        for (int j = 0; j < 8; ++j) {
                            const float z = j < 4 ? acc[ai][bj][m][0][j & 3] : acc[ai][bj][m][1][j & 3];
                            const float lbv = j < 4 ? l0[j & 3] : l1[j & 3];
                            const float e = __expf(-z);
                            const float r = __builtin_amdgcn_rcpf(1.0f + e);
                            const float sg = r, sgc = (e > 3.0e38f) ? 1.0f : e * r;
                            const float forget = lbv + (1.0f - lbv) * sg;
                            kk[j] = (1.0f - lbv) * sgc;
                            gg[j] = logf(forget);
                        }
                        u32x4 w; w.x = cvt_pk_bf16(kk[0], kk[1]); w.y = cvt_pk_bf16(kk[2], kk[3]); w.z = cvt_pk_bf16(kk[4], kk[5]); w.w = cvt_pk_bf16(kk[6], kk[7]);
                        *(u32x4*)(O + off) = w;
                        *(f32x4*)(ZG + off) = (f32x4){gg[0], gg[1], gg[2], gg[3]};
                        *(f32x4*)(ZG + off + 4) = (f32x4){gg[4], gg[5], gg[6], gg[7]};
                    }
            }
        } else {
            const bool act = (seg == 1) || (seg == 4);
#pragma unroll
            for (int ai = 0; ai < 2; ++ai)
#pragma unroll
                for (int m = 0; m < 4; ++m)
#pragma unroll
                    for (int bj = 0; bj < 2; ++bj) {
                        f32x4 v0 = acc[ai][bj][m][0], v1 = acc[ai][bj][m][1];
                        if (act) { v0 = (f32x4){silu_f(v0[0]), silu_f(v0[1]), silu_f(v0[2]), silu_f(v0[3])}; v1 = (f32x4){silu_f(v1[0]), silu_f(v1[1]), silu_f(v1[2]), silu_f(v1[3])}; }
                        u32x4 w; w.x = cvt_pk_bf16(v0[0], v0[1]); w.y = cvt_pk_bf16(v0[2], v0[3]); w.z = cvt_pk_bf16(v1[0], v1[1]); w.w = cvt_pk_bf16(v1[2], v1[3]);
                        *(u32x4*)(O + (size_t)(row0 + ai * HALF + m * 16) * HQK + col0 + bj * HALF) = w;
                    }
        }
    }
};
}

#define XB_TMO      128
#define XB_XCNT(j)  (256  + 64 * (j))
#define XB_XSUB(j)  (1280 + 64 * (j))
#define XB_XGEN(j)  (2304 + 64 * (j))
#define XB_TOP      3328
#define XB_TOPGEN   3392
#define XCD_BAR_WORDS 3456
#define XB_SPIN_CAP (1u << 18)

__device__ __forceinline__ unsigned xb_ld(unsigned* p)              { return __hip_atomic_load(p, __ATOMIC_RELAXED, __HIP_MEMORY_SCOPE_AGENT); }
__device__ __forceinline__ unsigned xb_add(unsigned* p, unsigned v) { return __hip_atomic_fetch_add(p, v, __ATOMIC_RELAXED, __HIP_MEMORY_SCOPE_AGENT); }
__device__ __forceinline__ unsigned xb_xcc_id() { return (unsigned)__builtin_amdgcn_s_getreg((3 << 11) | 20) & 0xFu; }
#define XB_SPIN(cond, bar) do { unsigned _sp = 0; while (cond) { __builtin_amdgcn_s_sleep(1); \
    if ((++_sp & 255u) == 0u) { if (xb_ld(&(bar)[XB_TMO])) break; if (_sp > XB_SPIN_CAP) { atomicAdd(&(bar)[XB_TMO], 1u); break; } } } } while (0)

struct XcdBarrier {
    unsigned* bar; unsigned x;
    volatile LAS unsigned* st;
};

__device__ __forceinline__ XcdBarrier xcd_barrier_post(unsigned* bar, volatile LAS unsigned* st) {
    XcdBarrier b; b.bar = bar; b.x = xb_xcc_id(); b.st = st;
    if (threadIdx.x == 0) (void)xb_add(&bar[XB_XCNT(b.x)], 1u);
    return b;
}
__device__ __forceinline__ void xcd_barrier_complete(unsigned* bar, unsigned x, unsigned& nloc, unsigned& nx) {
    const unsigned G = gridDim.x * gridDim.y * gridDim.z;
    unsigned sum, cnt, mine, sp = 0u;
    for (;;) {
        sum = 0u; cnt = 0u; mine = 0u;
#pragma unroll
        for (unsigned j = 0; j < 16; ++j) { const unsigned c = xb_ld(&bar[XB_XCNT(j)]); sum += c; cnt += (c > 0u) ? 1u : 0u; mine = (j == x) ? c : mine; }
        if (sum == G) break;
        __builtin_amdgcn_s_sleep(1);
        if ((++sp & 255u) == 0u) { if (xb_ld(&bar[XB_TMO])) break; if (sp > XB_SPIN_CAP) { atomicAdd(&bar[XB_TMO], 1u); break; } }
    }
    nloc = mine > 0u ? mine : 1u; nx = cnt > 0u ? cnt : 1u;
}

__device__ __forceinline__ void xcd_barrier(const XcdBarrier& b) {
    asm volatile("s_waitcnt vmcnt(0)" ::: "memory");
    __syncthreads();
    if (threadIdx.x == 0) {
        unsigned* bar = b.bar;
        __builtin_amdgcn_s_waitcnt(0);
        unsigned nloc = b.st[0], nx = b.st[1];
        if (nloc == 0u) { xcd_barrier_complete(bar, b.x, nloc, nx); b.st[0] = nloc; b.st[1] = nx; }
        const unsigned old = xb_add(&bar[XB_XSUB(b.x)], 1u);
        const unsigned gen = old / nloc;
        if (old + 1u == (gen + 1u) * nloc) {
            __builtin_amdgcn_fence(__ATOMIC_RELEASE, "agent");
            asm volatile("s_waitcnt vmcnt(0)" ::: "memory");
            const unsigned og = xb_add(&bar[XB_TOP], 1u);
            const unsigned tg = og / nx;
            if (og + 1u == (tg + 1u) * nx) xb_add(&bar[XB_TOPGEN], 1u);
            else XB_SPIN(xb_ld(&bar[XB_TOPGEN]) == tg, bar);
            __builtin_amdgcn_fence(__ATOMIC_ACQUIRE, "agent");
            xb_add(&bar[XB_XGEN(b.x)], 1u);
            asm volatile("s_waitcnt vmcnt(0)" ::: "memory");
        } else {
            XB_SPIN(xb_ld(&bar[XB_XGEN(b.x)]) == gen, bar);
            __builtin_amdgcn_fence(__ATOMIC_ACQUIRE, "agent");
            asm volatile("s_waitcnt vmcnt(0)" ::: "memory");
        }
    }
    __syncthreads();
}

struct Args { const float* in[20]; float* out; unsigned char* ws; int ph_lo, ph_hi; };

__device__ __forceinline__ void p0_mod(const Args& a, LAS unsigned char* lds, float* mod, int tid, int wave, int lane) {
    LAS float* cact = (LAS float*)lds;
    LAS float* red = (LAS float*)(lds + 32768);
    const float* c = a.in[1];
    for (int i = tid; i < NB * DM; i += 512) { const float v = c[i]; cact[i] = v / (1.0f + __expf(-v)); }
    __syncthreads();
    const float* W = a.in[2]; const float* bias = a.in[3];
    const int cl = lane & 15, kr = lane >> 4;
    for (int slab = blockIdx.x; slab < NMODC / 64; slab += gridDim.x) {
        const int n0 = slab * 64;
        f32x4 acc0 = {0.f, 0.f, 0.f, 0.f}, acc1 = acc0, acc2 = acc0, acc3 = acc0;
        const float* wp = W + (size_t)(wave * 4 + kr) * NMODC + n0 + 4 * cl;
#pragma unroll 8
        for (int i = 0; i < 64; ++i) {
            const int k = i * 32 + wave * 4 + kr;
            const f32x4 wv = *(const f32x4*)(wp + (size_t)i * 32 * NMODC);
            acc0 += cact[k] * wv; acc1 += cact[DM + k] * wv; acc2 += cact[2 * DM + k] * wv; acc3 += cact[3 * DM + k] * wv;
        }
#pragma unroll
        for (int j = 0; j < 4; ++j) {
            acc0[j] += __shfl_xor(acc0[j], 16); acc0[j] += __shfl_xor(acc0[j], 32);
            acc1[j] += __shfl_xor(acc1[j], 16); acc1[j] += __shfl_xor(acc1[j], 32);
            acc2[j] += __shfl_xor(acc2[j], 16); acc2[j] += __shfl_xor(acc2[j], 32);
            acc3[j] += __shfl_xor(acc3[j], 16); acc3[j] += __shfl_xor(acc3[j], 32);
        }
        if (kr == 0) {
            *(LAS f32x4*)(red + (wave * 4 + 0) * 64 + 4 * cl) = acc0; *(LAS f32x4*)(red + (wave * 4 + 1) * 64 + 4 * cl) = acc1;
            *(LAS f32x4*)(red + (wave * 4 + 2) * 64 + 4 * cl) = acc2; *(LAS f32x4*)(red + (wave * 4 + 3) * 64 + 4 * cl) = acc3;
        }
        __syncthreads();
        if (tid < 256) {
            const int b = tid >> 6, col = tid & 63; float s = bias[n0 + col];
#pragma unroll
            for (int w = 0; w < 8; ++w) s += red[(w * 4 + b) * 64 + col];
            mod[(size_t)b * NMODC + n0 + col] = s;
        }
        __syncthreads();
    }
}

__device__ __forceinline__ void transpose_item(const float* W, int K, int N, bf16_t* WT, int mode, int item, int lane) {
    const int nblk = N >> 5, kb = item / nblk, nb = item - kb * nblk, k0 = kb * 64, n0 = nb * 32;
    const int lk = lane >> 3, ln = lane & 7;
    const float* src = W + (size_t)(k0 + 8 * lk) * N + n0 + 4 * ln;
    f32x4 v[8];
#pragma unroll
    for (int i = 0; i < 8; ++i) v[i] = *(const f32x4*)(src + (size_t)i * N);
    const int nn = n0 + 4 * ln;
    const int rowb = mode == 0 ? nn : ((nn >> 7) * 256 + (nn & 127) + (mode == 2 ? 128 : 0));
#pragma unroll
    for (int j = 0; j < 4; ++j) {
        u32x4 o; o.x = pk2(v[0][j], v[1][j]); o.y = pk2(v[2][j], v[3][j]); o.z = pk2(v[4][j], v[5][j]); o.w = pk2(v[6][j], v[7][j]);
        *(u32x4*)(WT + (size_t)(rowb + j) * K + k0 + 8 * lk) = o;
    }
}
__device__ __forceinline__ void p0_weights(const Args& a, unsigned char* ws, int gw, int ngw, int lane) {
    constexpr int I_GU = (DM / 64) * (DFF / 32), I_DN = (DFF / 64) * (DM / 32), I_IN = (DM / 64) * (INW / 32), I_OUT = (DM / 64) * (DM / 32), I_PW = (256 / 64) * (256 / 32);
    constexpr int NITEMS = 4 * I_GU + 2 * I_DN + I_IN + I_OUT + 4 * I_PW;
    for (int it = gw; it < NITEMS; it += ngw) {
        int r = it;
        if (r < I_GU) { transpose_item(a.in[5], DM, DFF, (bf16_t*)(ws + WS_WGU1), 1, r, lane); continue; } r -= I_GU;
        if (r < I_GU) { transpose_item(a.in[6], DM, DFF, (bf16_t*)(ws + WS_WGU1), 2, r, lane); continue; } r -= I_GU;
        if (r < I_DN) { transpose_item(a.in[7], DFF, DM, (bf16_t*)(ws + WS_WD1), 0, r, lane); continue; } r -= I_DN;
        if (r < I_IN) { transpose_item(a.in[9], DM, INW, (bf16_t*)(ws + WS_WIN), 0, r, lane); continue; } r -= I_IN;
        if (r < I_OUT) { transpose_item(a.in[14], DM, DM, (bf16_t*)(ws + WS_WOUT), 0, r, lane); continue; } r -= I_OUT;
        if (r < I_GU) { transpose_item(a.in[16], DM, DFF, (bf16_t*)(ws + WS_WGU2), 1, r, lane); continue; } r -= I_GU;
        if (r < I_GU) { transpose_item(a.in[17], DM, DFF, (bf16_t*)(ws + WS_WGU2), 2, r, lane); continue; } r -= I_GU;
        if (r < I_DN) { transpose_item(a.in[18], DFF, DM, (bf16_t*)(ws + WS_WD2), 0, r, lane); continue; } r -= I_DN;
        const int g = r / I_PW; r -= g * I_PW;
        transpose_item(a.in[10] + (size_t)g * 65536, 256, 256, (bf16_t*)(ws + WS_PWT) + (size_t)g * 65536, 0, r, lane);
    }
}

template <int MODE> __device__ __forceinline__ void norm_phase(const float* X, const float* w, const float* shift, const float* scale, bf16_t* H, float* outp, int gw, int ngw, int lane) {
    for (int row = gw; row < MT; row += ngw) {
        const f32x4* xr = (const f32x4*)(X + (size_t)row * DM) + lane;
        f32x4 v[8]; float ss = 0.f;
#pragma unroll
        for (int j = 0; j < 8; ++j) { v[j] = xr[64 * j]; ss += (v[j][0] * v[j][0] + v[j][1] * v[j][1]) + (v[j][2] * v[j][2] + v[j][3] * v[j][3]); }
        const float r = 1.0f / sqrtf(wave_sum(ss) * (1.0f / DM) + EPS);
        const int b = row >> 11;
#pragma unroll
        for (int j = 0; j < 8; ++j) {
            const int col = 4 * (lane + 64 * j);
            const f32x4 wv = *(const f32x4*)(w + col);
            f32x4 y = v[j] * r * wv;
            if (MODE == 0) {
                const f32x4 sc = *(const f32x4*)(scale + (size_t)b * NMODC + col), sh = *(const f32x4*)(shift + (size_t)b * NMODC + col);
                y = y * (1.0f + sc) + sh;
                u32x2 o; o.x = pk2(y[0], y[1]); o.y = pk2(y[2], y[3]);
                *(u32x2*)(H + (size_t)row * DM + col) = o;
            } else {
                *(f32x4*)(outp + (size_t)row * DM + col) = y;
            }
        }
    }
}

__device__ __forceinline__ void pool_unit(const bf16_t* ZP, const bf16_t* PWT, const float* pscale, bf16_t* MIX, LAS unsigned char* lds, int pu, int tid, int wave, int lane) {
    const int g = pu & 3, rt = pu >> 2, R0 = rt * 64, t0 = R0 & (SEQ - 1), w = 2 << g;
    constexpr int AST = 528;
    {
        const int c = tid & 255, sg = tid >> 8, ts = t0 + sg * 32;
        const bf16_t* up = ZP + (size_t)(R0 + sg * 32) * PW + g * 256 + c;
        float win = 0.f;
        for (int j = 1; j < w; ++j) if (ts - j >= 0) win += bf2f(up[-(ptrdiff_t)j * PW]);
#pragma unroll 4
        for (int i = 0; i < 32; ++i) {
            const int t = ts + i;
            const float cur = bf2f(up[(ptrdiff_t)i * PW]);
            win += cur;
            const float cnt = (float)(t + 1 < w ? t + 1 : w);
            const float pooled = win / cnt - cur;
            *(LAS bf16_t*)(lds + (sg * 32 + i) * AST + c * 2) = (bf16_t)(pk2(pooled, 0.f) & 0xffffu);
            if (t - w + 1 >= 0) win -= bf2f(up[(ptrdiff_t)(i - w + 1) * PW]);
        }
    }
    __syncthreads();
    const int fr = lane & 15, fq = lane >> 4;
    bf16x8 wf[2][8];
#pragma unroll
    for (int j = 0; j < 2; ++j)
#pragma unroll
        for (int ks = 0; ks < 8; ++ks) wf[j][ks] = *(const bf16x8*)(PWT + (size_t)g * 65536 + (size_t)(32 * wave + 16 * j + fr) * 256 + 32 * ks + 8 * fq);
#pragma unroll
    for (int tt = 0; tt < 4; ++tt) {
        f32x4 acc[2] = {{0.f, 0.f, 0.f, 0.f}, {0.f, 0.f, 0.f, 0.f}};
#pragma unroll
        for (int ks = 0; ks < 8; ++ks) {
            const bf16x8 bfrag = *(const LAS bf16x8*)(lds + (16 * tt + fr) * AST + (32 * ks + 8 * fq) * 2);
#pragma unroll
            for (int j = 0; j < 2; ++j) acc[j] = __builtin_amdgcn_mfma_f32_16x16x32_bf16(wf[j][ks], bfrag, acc[j], 0, 0, 0);
        }
#pragma unroll
        for (int j = 0; j < 2; ++j) {
            const int col = g * 256 + 32 * wave + 16 * j + 4 * fq;
            const f32x4 ps = *(const f32x4*)(pscale + col);
            const f32x4 y = acc[j] * ps;
            u32x2 o; o.x = pk2(y[0], y[1]); o.y = pk2(y[2], y[3]);
            *(u32x2*)(MIX + (size_t)(R0 + 16 * tt + fr) * DM + col) = o;
        }
    }
    __syncthreads();
}

struct HgrnT { const bf16_t *ZQ, *ZK, *ZV, *ZS; const float* ZG; float* ST; float* ADEC; const float* gnorm; bf16_t* MIX; };
template <int PASS> __device__ __forceinline__ void hgrn_unit(const HgrnT& T, LAS unsigned char* lds, int unit, int tid, int wave, int lane) {
    const int c = unit & 31, bh = unit >> 5, h = bh & 7, b = bh >> 3, R0 = b * SEQ + c * 64;
    if (PASS == 1 && c == 31) return;
    const int d = tid & 127, sg = tid >> 7, fr = lane & 15, fq = lane >> 4;
    constexpr int TS = 144, DS = 272;
    LAS float* SEG = (LAS float*)lds;
    LAS unsigned char* QT = lds + 2048;
    LAS unsigned char* KT = lds + 19456;
    LAS unsigned char* VT = lds + 36864;
    LAS unsigned char* SP = lds + 55296;
    LAS unsigned char* AT = lds + 90112;
    LAS float* SSQ = (LAS float*)(lds + 99328);
    const size_t base = (size_t)(R0 + sg * 16) * HQK + h * 128 + d;
    float bb[16];
#pragma unroll
    for (int i = 0; i < 16; ++i) bb[i] = T.ZG[base + (size_t)i * HQK];
    float run = 0.f;
#pragma unroll
    for (int i = 0; i < 16; ++i) { run += bb[i]; bb[i] = run; }
    SEG[sg * 128 + d] = run;
    __syncthreads();
    float pre = 0.f, tot = 0.f;
#pragma unroll
    for (int s = 0; s < 4; ++s) { const float v = SEG[s * 128 + d]; tot += v; if (s < sg) pre += v; }
#pragma unroll
    for (int i = 0; i < 16; ++i) bb[i] += pre;
    {
        unsigned pv[8];
#pragma unroll
        for (int i = 0; i < 8; ++i) pv[i] = (unsigned)T.ZV[base + (size_t)(2 * i) * HQK] | ((unsigned)T.ZV[base + (size_t)(2 * i + 1) * HQK] << 16);
        *(LAS u32x4*)(VT + d * TS + sg * 32) = (u32x4){pv[0], pv[1], pv[2], pv[3]};
        *(LAS u32x4*)(VT + d * TS + sg * 32 + 16) = (u32x4){pv[4], pv[5], pv[6], pv[7]};
    }
    if (PASS == 1) {
        if (sg == 0) T.ADEC[(size_t)unit * 128 + d] = __expf(tot);
        unsigned pkk[8];
#pragma unroll
        for (int i = 0; i < 8; ++i) {
            const float k0 = bf2f(T.ZK[base + (size_t)(2 * i) * HQK]) * __expf(tot - bb[2 * i]);
            const float k1 = bf2f(T.ZK[base + (size_t)(2 * i + 1) * HQK]) * __expf(tot - bb[2 * i + 1]);
            pkk[i] = pk2(k0, k1);
        }
        *(LAS u32x4*)(SP + d * TS + sg * 32) = (u32x4){pkk[0], pkk[1], pkk[2], pkk[3]};
        *(LAS u32x4*)(SP + d * TS + sg * 32 + 16) = (u32x4){pkk[4], pkk[5], pkk[6], pkk[7]};
        __syncthreads();
        bf16x8 bfr[2];
#pragma unroll
        for (int ks = 0; ks < 2; ++ks) bfr[ks] = *(const LAS bf16x8*)(VT + (16 * wave + fr) * TS + (32 * ks + 8 * fq) * 2);
        float* stp = T.ST + (size_t)unit * 16384 + (size_t)(16 * wave + fr) * 128 + 4 * fq;
#pragma unroll
        for (int dt = 0; dt < 8; ++dt) {
            f32x4 acc = {0.f, 0.f, 0.f, 0.f};
#pragma unroll
            for (int ks = 0; ks < 2; ++ks) {
                const bf16x8 afr = *(const LAS bf16x8*)(SP + (16 * dt + fr) * TS + (32 * ks + 8 * fq) * 2);
                acc = __builtin_amdgcn_mfma_f32_16x16x32_bf16(afr, bfr[ks], acc, 0, 0, 0);
            }
            *(f32x4*)(stp + 16 * dt) = acc;
        }
        __syncthreads();
    } else {
#pragma unroll
        for (int i = 0; i < 16; ++i) {
            const size_t o = base + (size_t)i * HQK;
            const float e = __expf(bb[i]);
            const float qt = bf2f(T.ZQ[o]) * e;
            const float kt = bf2f(T.ZK[o]) * __builtin_amdgcn_rcpf(e);
            *(LAS bf16_t*)(QT + (sg * 16 + i) * DS + d * 2) = (bf16_t)(pk2(qt, 0.f) & 0xffffu);
            *(LAS bf16_t*)(KT + (sg * 16 + i) * DS + d * 2) = (bf16_t)(pk2(kt, 0.f) & 0xffffu);
        }
        {
            const float* sp = T.ST + (size_t)unit * 16384;
#pragma unroll
            for (int j = 0; j < 8; ++j) {
                const int idx = tid + 512 * j, v = idx >> 5, d4 = idx & 31;
                const f32x4 s4 = *(const f32x4*)(sp + (size_t)idx * 4);
                u32x2 o; o.x = pk2(s4[0], s4[1]); o.y = pk2(s4[2], s4[3]);
                *(LAS u32x2*)(SP + v * DS + d4 * 8) = o;
            }
        }
        __syncthreads();
        {
            const int tt = wave >> 1;
#pragma unroll
            for (int jj = 0; jj < 2; ++jj) {
                const int st = (wave & 1) * 2 + jj;
                f32x4 acc = {0.f, 0.f, 0.f, 0.f};
                if (st <= tt) {
#pragma unroll
                    for (int ks = 0; ks < 4; ++ks) {
                        const bf16x8 afr = *(const LAS bf16x8*)(KT + (16 * st + fr) * DS + (32 * ks + 8 * fq) * 2);
                        const bf16x8 bfr = *(const LAS bf16x8*)(QT + (16 * tt + fr) * DS + (32 * ks + 8 * fq) * 2);
                        acc = __builtin_amdgcn_mfma_f32_16x16x32_bf16(afr, bfr, acc, 0, 0, 0);
                    }
                    const int t = 16 * tt + fr, s0 = 16 * st + 4 * fq;
#pragma unroll
                    for (int r = 0; r < 4; ++r) if (s0 + r > t) acc[r] = 0.f;
                }
                u32x2 o; o.x = pk2(acc[0], acc[1]); o.y = pk2(acc[2], acc[3]);
                *(LAS u32x2*)(AT + (16 * tt + fr) * TS + (16 * st + 4 * fq) * 2) = o;
            }
        }
        __syncthreads();
        {
            const int tt = wave >> 1, t = 16 * tt + fr;
            f32x4 o4[4]; float ssq = 0.f;
            bf16x8 ba[2], bq[4];
#pragma unroll
            for (int ks = 0; ks < 2; ++ks) ba[ks] = *(const LAS bf16x8*)(AT + t * TS + (32 * ks + 8 * fq) * 2);
#pragma unroll
            for (int ks = 0; ks < 4; ++ks) bq[ks] = *(const LAS bf16x8*)(QT + t * DS + (32 * ks + 8 * fq) * 2);
#pragma unroll
            for (int jj = 0; jj < 4; ++jj) {
                const int vt = (wave & 1) * 4 + jj;
                f32x4 acc = {0.f, 0.f, 0.f, 0.f};
#pragma unroll
                for (int ks = 0; ks < 2; ++ks) acc = __builtin_amdgcn_mfma_f32_16x16x32_bf16(*(const LAS bf16x8*)(VT + (16 * vt + fr) * TS + (32 * ks + 8 * fq) * 2), ba[ks], acc, 0, 0, 0);
#pragma unroll
                for (int ks = 0; ks < 4; ++ks) acc = __builtin_amdgcn_mfma_f32_16x16x32_bf16(*(const LAS bf16x8*)(SP + (16 * vt + fr) * DS + (32 * ks + 8 * fq) * 2), bq[ks], acc, 0, 0, 0);
                o4[jj] = acc;
                ssq += (acc[0] * acc[0] + acc[1] * acc[1]) + (acc[2] * acc[2] + acc[3] * acc[3]);
            }
            ssq += __shfl_xor(ssq, 16); ssq += __shfl_xor(ssq, 32);
            if (fq == 0) SSQ[(wave & 1) * 64 + t] = ssq;
            __syncthreads();
            const float rinv = 1.0f / sqrtf((SSQ[t] + SSQ[64 + t]) * (1.0f / 128.0f) + EPS);
#pragma unroll
            for (int jj = 0; jj < 4; ++jj) {
                const int v0 = 16 * ((wave & 1) * 4 + jj) + 4 * fq;
                const f32x4 gw = *(const f32x4*)(T.gnorm + v0);
                const u32x2 zs = *(const u32x2*)(T.ZS + (size_t)(R0 + t) * HQK + h * 128 + v0);
                const f32x4 y = o4[jj] * rinv * gw * (f32x4){bf2f(zs.x & 0xffffu), bf2f(zs.x >> 16), bf2f(zs.y & 0xffffu), bf2f(zs.y >> 16)};
                u32x2 o; o.x = pk2(y[0], y[1]); o.y = pk2(y[2], y[3]);
                *(u32x2*)(T.MIX + (size_t)(R0 + t) * DM + PW + h * 128 + v0) = o;
            }
        }
        __syncthreads();
    }
}

__device__ __forceinline__ void scan_phase(float* ST, const float* ADEC, int tid) {
    for (int e = blockIdx.x * 512 + tid; e < 32 * 4096; e += gridDim.x * 512) {
        const int bh = e >> 12, within = e & 4095, d4 = within & 31;
        float* st = ST + (size_t)bh * 32 * 16384 + (size_t)within * 4;
        const float* ad = ADEC + (size_t)bh * 32 * 128 + d4 * 4;
        f32x4 S = {0.f, 0.f, 0.f, 0.f};
        for (int cb = 0; cb < 4; ++cb) {
            f32x4 L[8], A[8];
#pragma unroll
            for (int j = 0; j < 8; ++j) { L[j] = *(const f32x4*)(st + (size_t)(cb * 8 + j) * 16384); A[j] = *(const f32x4*)(ad + (cb * 8 + j) * 128); }
#pragma unroll
            for (int j = 0; j < 8; ++j) { *(f32x4*)(st + (size_t)(cb * 8 + j) * 16384) = S; S = A[j] * S + L[j]; }
        }
    }
}

__global__ void __launch_bounds__(512, 2) fwd_megakernel(Args a) {
    extern __shared__ __attribute__((aligned(16))) unsigned char lds_raw[];
    LAS unsigned char* lds = (LAS unsigned char*)lds_raw;
    cg::grid_group grid = cg::this_grid();
    const int tid = threadIdx.x, lane = tid & 63, wave = __builtin_amdgcn_readfirstlane(tid >> 6);
    const int G = gridDim.x, gw = blockIdx.x * 8 + wave, ngw = G * 8;
    unsigned char* ws = a.ws;
    if (tid < 16) ((LAS unsigned*)(lds + LDS_MISC))[tid] = 0u;
    __syncthreads();
    const XcdBarrier xbar = xcd_barrier_post((unsigned*)(ws + WS_BAR), (volatile LAS unsigned*)(lds + LDS_MISC));
    float* mod = (float*)(ws + WS_MOD); float* lbv = (float*)(ws + WS_LB);
    bf16_t* H = (bf16_t*)(ws + WS_H); float* X = (float*)(ws + WS_X); bf16_t* MIX = (bf16_t*)(ws + WS_MIX); bf16_t* HID = (bf16_t*)(ws + WS_HID);

    const int lo = a.ph_lo, hi = a.ph_hi;
#define IN(k) (lo <= (k) && (k) < hi)
#define SEAM(k) do { if ((k) + 1 < hi) { if ((k) == PH_PRO) grid.sync(); else xcd_barrier(xbar); } } while (0)
    if (IN(PH_PRO)) {
#ifndef SKIP_PRO
      for (int rep = 0; rep < REP_PRO; ++rep) { if (rep) grid.sync();
        p0_mod(a, lds, mod, tid, wave, lane);
        if (blockIdx.x == 0) {
            const float* l = a.in[12];
            for (int j = tid; j < HQK; j += 512) {
                const float l0 = l[j], l1 = l[HQK + j], m = fmaxf(l0, l1), e0 = __expf(l0 - m), e1 = __expf(l1 - m), s = e0 + e1, p0 = e0 / s, p1 = e1 / s;
                lbv[j] = (p0 + p1) - p0;
            }
        }
        p0_weights(a, ws, gw, ngw, lane);
      }
#endif
        SEAM(PH_PRO);
    }
    if (IN(PH_N1)) { for (int rep = 0; rep < REP_N1; ++rep) { if (rep) grid.sync(); norm_phase<0>(a.in[0], a.in[4], mod + 0 * DM, mod + 1 * DM, H, nullptr, gw, ngw, lane); } SEAM(PH_N1); }
    if (IN(PH_GU1)) {
#ifndef SKIP_GU
        pg8::Gemm g{H, (const bf16_t*)(ws + WS_WGU1), MT, 2 * DFF, DM};
        pg8::StaticOrder S; S.init(MT, 2 * DFF, G, (int)blockIdx.x);
        pg8::EpiSwiglu E{HID, DFF};
        for (int rep = 0; rep < REP_GU1; ++rep) { if (rep) grid.sync();
        pg8::gemm_phase<pg8::EpiSwiglu, pg8::StaticOrder, true, true>(lds, g, S, E); }
#endif
        SEAM(PH_GU1);
    }
    if (IN(PH_DN1)) {
#ifndef SKIP_DN
        pg8::Gemm g{HID, (const bf16_t*)(ws + WS_WD1), MT, DM, DFF};
        pg8::StaticOrder S; S.init(MT, DM, G, (int)blockIdx.x);
        pg8::EpiResid E{a.in[0], X, mod + 2 * DM, 0.5f};
        for (int rep = 0; rep < REP_DN1; ++rep) { if (rep) grid.sync();
        pg8::gemm_phase<pg8::EpiResid, pg8::StaticOrder, true, true>(lds, g, S, E); }
#endif
        SEAM(PH_DN1);
    }
    if (IN(PH_N2)) { norm_phase<0>(X, a.in[8], mod + 3 * DM, mod + 4 * DM, H, nullptr, gw, ngw, lane); SEAM(PH_N2); }
    if (IN(PH_WIN)) {
#ifndef SKIP_WIN
        pg8::Gemm g{H, (const bf16_t*)(ws + WS_WIN), MT, INW, DM};
        pg8::StaticOrder S; S.init(MT, INW, G, (int)blockIdx.x);
        pg8::EpiWin E{(bf16_t*)(ws + WS_ZP), (bf16_t*)(ws + WS_ZQ), (bf16_t*)(ws + WS_ZK), (bf16_t*)(ws + WS_ZV), (bf16_t*)(ws + WS_ZS), (float*)(ws + WS_ZG), lbv};
        for (int rep = 0; rep < REP_WIN; ++rep) { if (rep) grid.sync();
        pg8::gemm_phase<pg8::EpiWin, pg8::StaticOrder, true, true>(lds, g, S, E); }
#endif
        SEAM(PH_WIN);
    }
#ifndef SKIP_MIX
    if (IN(PH_MIXA)) {
        HgrnT T{(const bf16_t*)(ws + WS_ZQ), (const bf16_t*)(ws + WS_ZK), (const bf16_t*)(ws + WS_ZV), (const bf16_t*)(ws + WS_ZS), (const float*)(ws + WS_ZG),
                (float*)(ws + WS_ST), (float*)(ws + WS_ADEC), a.in[13], MIX};
        for (int rep = 0; rep < REP_MIXA; ++rep) { if (rep) grid.sync();
        for (int it = blockIdx.x; it < 1024 + 512; it += G) {
            if (it < 1024) hgrn_unit<1>(T, lds, it, tid, wave, lane);
            else pool_unit((const bf16_t*)(ws + WS_ZP), (const bf16_t*)(ws + WS_PWT), a.in[11], MIX, lds, it - 1024, tid, wave, lane);
        } }
        SEAM(PH_MIXA);
    }
    if (IN(PH_SCAN)) { scan_phase((float*)(ws + WS_ST), (const float*)(ws + WS_ADEC), tid); SEAM(PH_SCAN); }
    if (IN(PH_MIXB)) {
        HgrnT T{(const bf16_t*)(ws + WS_ZQ), (const bf16_t*)(ws + WS_ZK), (const bf16_t*)(ws + WS_ZV), (const bf16_t*)(ws + WS_ZS), (const float*)(ws + WS_ZG),
                (float*)(ws + WS_ST), (float*)(ws + WS_ADEC), a.in[13], MIX};
        for (int rep = 0; rep < REP_MIXB; ++rep) { if (rep) grid.sync();
        for (int it = blockIdx.x; it < 1024; it += G) hgrn_unit<3>(T, lds, it, tid, wave, lane); }
        SEAM(PH_MIXB);
    }
#endif
    if (IN(PH_WOUT)) {
#ifndef SKIP_DN
        pg8::Gemm g{MIX, (const bf16_t*)(ws + WS_WOUT), MT, DM, DM};
        pg8::StaticOrder S; S.init(MT, DM, G, (int)blockIdx.x);
        pg8::EpiResid E{X, X, mod + 5 * DM, 1.0f};
        pg8::gemm_phase<pg8::EpiResid, pg8::StaticOrder, true, true>(lds, g, S, E);
#endif
        SEAM(PH_WOUT);
    }
    if (IN(PH_N3)) { norm_phase<0>(X, a.in[15], mod + 6 * DM, mod + 7 * DM, H, nullptr, gw, ngw, lane); SEAM(PH_N3); }
    if (IN(PH_GU2)) {
#ifndef SKIP_GU
        pg8::Gemm g{H, (const bf16_t*)(ws + WS_WGU2), MT, 2 * DFF, DM};
        pg8::StaticOrder S; S.init(MT, 2 * DFF, G, (int)blockIdx.x);
        pg8::EpiSwiglu E{HID, DFF};
        pg8::gemm_phase<pg8::EpiSwiglu, pg8::StaticOrder, true, true>(lds, g, S, E);
#endif
        SEAM(PH_GU2);
    }
    if (IN(PH_DN2)) {
#ifndef SKIP_DN
        pg8::Gemm g{HID, (const bf16_t*)(ws + WS_WD2), MT, DM, DFF};
        pg8::StaticOrder S; S.init(MT, DM, G, (int)blockIdx.x);
        pg8::EpiResid E{X, X, mod + 8 * DM, 0.5f};
        pg8::gemm_phase<pg8::EpiResid, pg8::StaticOrder, true, true>(lds, g, S, E);
#endif
        SEAM(PH_DN2);
    }
    if (IN(PH_FIN)) norm_phase<1>(X, a.in[19], nullptr, nullptr, nullptr, a.out, gw, ngw, lane);
#undef IN
#undef SEAM
}

extern "C" void kernel_launch(void* const* d_in, const int* in_sizes, int n_in, void* d_out, int out_size, void* d_ws, size_t ws_size, hipStream_t stream) {
    static int grid = 0;
    if (grid == 0) {
        if (n_in != 20 || in_sizes[0] != MT * DM || out_size != MT * DM || ws_size < WS_END) {
            fprintf(stderr, "kernel_launch: unexpected problem (n_in %d, in0 %d, out %d, ws %zu); nothing launched\n", n_in, n_in > 0 ? in_sizes[0] : -1, out_size, ws_size); grid = -1; return; }
        int dev = 0, cus = 0, per_cu = 0;
        if (hipGetDevice(&dev) != hipSuccess || hipDeviceGetAttribute(&cus, hipDeviceAttributeMultiprocessorCount, dev) != hipSuccess) { grid = -1; return; }
        if (hipFuncSetAttribute((const void*)fwd_megakernel, hipFuncAttributeMaxDynamicSharedMemorySize, LDS_BYTES) != hipSuccess) { fprintf(stderr, "kernel_launch: hipFuncSetAttribute failed\n"); grid = -1; return; }
        if (hipOccupancyMaxActiveBlocksPerMultiprocessor(&per_cu, (const void*)fwd_megakernel, 512, LDS_BYTES) != hipSuccess || per_cu < 1) { fprintf(stderr, "kernel_launch: occupancy query failed (%d)\n", per_cu); (void)hipGetLastError(); grid = -1; return; }
        grid = cus * per_cu;
    }
    if (grid < 0) return;
    if (hipMemsetAsync((unsigned char*)d_ws + WS_BAR, 0, XCD_BAR_WORDS * 4, stream) != hipSuccess) { fprintf(stderr, "kernel_launch: memset of the barrier words failed\n"); return; }
    Args a{};
    for (int i = 0; i < 20; ++i) a.in[i] = (const float*)d_in[i];
    a.out = (float*)d_out; a.ws = (unsigned char*)d_ws;
    for (int li = 0; li < MK_N_LAUNCHES; ++li) {
        a.ph_lo = (MK_N_LAUNCHES == 1) ? 0 : li; a.ph_hi = (MK_N_LAUNCHES == 1) ? NPH : li + 1;
        void* args[] = {&a};
        const hipError_t e = hipLaunchCooperativeKernel((const void*)fwd_megakernel, dim3(grid), dim3(512), args, LDS_BYTES, stream);
        if (e != hipSuccess) { fprintf(stderr, "kernel_launch: cooperative launch failed: %s (grid %d)\n", hipGetErrorString(e), grid); break; }
    }
}
```

```cpp
#include <hip/hip_runtime.h>
#include <hip/hip_cooperative_groups.h>
#include <cstdio>
#include <cstdint>
namespace cg = cooperative_groups;
namespace pg8 {
#define PG8_LAS __attribute__((address_space(3)))
typedef unsigned short bf16_t;
typedef short bf16x8 __attribute__((ext_vector_type(8)));
typedef float f32x4 __attribute__((ext_vector_type(4)));
typedef unsigned u32x4 __attribute__((ext_vector_type(4)));
constexpr int BM = 256, BK = 64, HALF = 128, HTB = HALF * BK * 2  , STAGE_BYTES = 8 * HTB, NXCD = 8, WGM = 8;

__host__ __device__ __forceinline__ int lds_byte(int r, int c) { const int st = (r >> 4) * 2 + (c >> 5), rr = r & 15, cc = c & 31, ob = rr * 64 + cc * 2; return st * 1024 + (ob ^ (((ob >> 9) & 1) << 5)); }
__host__ __device__ __forceinline__ void stage_rc(int b, int& R, int& C) { const int st = b / 1024, sb = b % 1024, swz = sb ^ (((sb >> 9) & 1) << 5); R = (st >> 1) * 16 + swz / 64; C = (st & 1) * 32 + (swz % 64) / 2; }
__host__ __device__ __forceinline__ int perm32(int rho) { const int n = rho >> 4, i = rho & 15; return 8 * (i >> 2) + 4 * n + (i & 3); }

struct Unit { int pm, pn; };
struct Gemm { const bf16_t* A; const bf16_t* Bt; int M, N, K; };

struct StaticOrder {
    int nM, nN, nwg, G, c;
    __host__ __device__ void init(int M, int N, int G_, int c_) { nM = M / BM; nN = N / BM; nwg = nM * nN; G = G_; c = c_; }
    __host__ __device__ bool next(int i, Unit& u) const {
        const long L = (long)i * G + c; if (L >= nwg) return false;
        int wgid = (int)L; { const int q = nwg / NXCD, r = nwg % NXCD, xcd = wgid % NXCD, off = wgid / NXCD; wgid = (xcd < r ? xcd * (q + 1) : r * (q + 1) + (xcd - r) * q) + off; }
        const int nig = WGM * nN, gid = wgid / nig, fm = gid * WGM, gsz = (nM - fm) < WGM ? (nM - fm) : WGM;
        u.pm = fm + ((wgid % nig) % gsz); u.pn = (wgid % nig) / gsz; return true;
    }
    __device__ __forceinline__ void a_ready(const Unit&) const {}
    __device__ __forceinline__ void done(const Unit&) const {}
};

__device__ __forceinline__ unsigned cvt_pk_bf16(float lo, float hi) { unsigned r; asm volatile("v_cvt_pk_bf16_f32 %0, %1, %2" : "=v"(r) : "v"(lo), "v"(hi)); return r; }
typedef float f32x2 __attribute__((ext_vector_type(2)));
template <class Epi, class Sched, bool ALIGN_EPI = false, bool SP2 = false>
__device__ __forceinline__ void gemm_phase(PG8_LAS unsigned char* lds, const Gemm g, const Sched& S, const Epi& E) {
    const int tid = threadIdx.x, wid = __builtin_amdgcn_readfirstlane(tid >> 6), lane = tid & 63, wr = wid >> 2, wc = wid & 3, fr = lane & 15, fq = lane >> 4;
    const int K = g.K, nt = K / BK;
    unsigned voffA[2], voffB[2];
#pragma unroll
    for (int i = 0; i < 2; ++i) { int R, C; stage_rc(tid * 16 + i * 8192, R, C); const int Rb = Epi::PERM ? ((R & ~31) + perm32(R & 31)) : R;
        voffA[i] = (unsigned)(R * K + C) * 2u; voffB[i] = (unsigned)(Rb * K + C) * 2u; }
    const size_t kstep = (size_t)(BK * 2);
    const size_t hstep = (size_t)HALF * K * 2;
    const size_t tstep = 2 * hstep;
    const unsigned ldsw = (unsigned)wid * 1024u;
    const int aoff = lds_byte(wr * 64 + fr, fq * 8), boff = lds_byte(wc * 32 + fr, fq * 8);
#define PG8_SA(b, h) (((b) * 2 + (h)) * HTB)
#define PG8_SB(b, h) ((4 + (b) * 2 + (h)) * HTB)
#define PG8_STAGE(bufoff, gbase, voff) do { _Pragma("unroll") for (int _i = 0; _i < 2; ++_i) \
        __builtin_amdgcn_global_load_lds((const unsigned*)((const char*)(gbase) + (voff)[_i]), (PG8_LAS unsigned*)(lds + (bufoff) + ldsw + _i * 8192), 16, 0, 0); } while (0)
#define PG8_LDA(dst, b, h) do { _Pragma("unroll") for (int m = 0; m < 4; ++m) _Pragma("unroll") for (int k = 0; k < 2; ++k) dst[m][k] = *(const PG8_LAS bf16x8*)(lds + PG8_SA(b, h) + aoff + m * 2048 + k * 1024); } while (0)
#define PG8_LDB(dst, b, h) do { _Pragma("unroll") for (int n = 0; n < 2; ++n) _Pragma("unroll") for (int k = 0; k < 2; ++k) dst[n][k] = *(const PG8_LAS bf16x8*)(lds + PG8_SB(b, h) + boff + n * 2048 + k * 1024); } while (0)
#define PG8_MMA(ai, bj, At, Bt) do { __builtin_amdgcn_s_setprio(1); _Pragma("unroll") for (int m = 0; m < 4; ++m) _Pragma("unroll") for (int n = 0; n < 2; ++n) _Pragma("unroll") for (int k = 0; k < 2; ++k) \
        acc[ai][bj][m][n] = __builtin_amdgcn_mfma_f32_16x16x32_bf16(Bt[n][k], At[m][k], acc[ai][bj][m][n], 0, 0, 0); __builtin_amdgcn_s_setprio(0); } while (0)
#define PG8_WAIT_V(n) asm volatile("s_waitcnt vmcnt(" #n ")" ::: "memory")
#define PG8_WAIT_L(n) asm volatile("s_waitcnt lgkmcnt(" #n ")" ::: "memory")
#define PG8_BAR __builtin_amdgcn_s_barrier()
#define PG8_SCHED __builtin_amdgcn_sched_barrier(0)
    Unit cur, nxt; int ui = 0;
    if (!S.next(0, cur)) return;
    f32x4 acc[2][2][4][2];
#pragma unroll
    for (int a = 0; a < 2; ++a)
#pragma unroll
        for (int b = 0; b < 2; ++b)
#pragma unroll
            for (int m = 0; m < 4; ++m)
#pragma unroll
                for (int n = 0; n < 2; ++n) acc[a][b][m][n] = (f32x4){0.f, 0.f, 0.f, 0.f};
    bf16x8 At[4][2], B0[2][2], B1[2][2];
    const char* cA = (const char*)g.A + (size_t)cur.pm * tstep; const char* cB = (const char*)g.Bt + (size_t)cur.pn * tstep;
    S.a_ready(cur);
    if constexpr (SP2) {
        PG8_STAGE(PG8_SB(0, 0), cB, voffB); PG8_STAGE(PG8_SB(0, 1), cB + hstep, voffB); PG8_STAGE(PG8_SA(0, 0), cA, voffA); PG8_STAGE(PG8_SA(0, 1), cA + hstep, voffA);
        if (wr == 1) PG8_BAR;
        PG8_WAIT_V(2); PG8_BAR;
        PG8_STAGE(PG8_SB(1, 0), cB + kstep, voffB); PG8_STAGE(PG8_SA(1, 0), cA + kstep, voffA); PG8_STAGE(PG8_SB(1, 1), cB + hstep + kstep, voffB);
        PG8_WAIT_V(6); PG8_BAR;
    } else {
        PG8_STAGE(PG8_SB(0, 0), cB, voffB); PG8_STAGE(PG8_SA(0, 0), cA, voffA); PG8_STAGE(PG8_SB(0, 1), cB + hstep, voffB); PG8_STAGE(PG8_SA(0, 1), cA + hstep, voffA);
        if (wr == 1) PG8_BAR;
        PG8_WAIT_V(4); PG8_BAR;
        PG8_STAGE(PG8_SB(1, 0), cB + kstep, voffB); PG8_STAGE(PG8_SA(1, 0), cA + kstep, voffA); PG8_STAGE(PG8_SB(1, 1), cB + hstep + kstep, voffB);
        PG8_WAIT_V(6); PG8_BAR;
    }
    for (;;) {
        const bool has_next = S.next(ui + 1, nxt);
        const char* nA = has_next ? (const char*)g.A + (size_t)nxt.pm * tstep : cA; const char* nB = has_next ? (const char*)g.Bt + (size_t)nxt.pn * tstep : cB;
        for (int t = 0; t < nt; t += 2) {
            const bool last = (t == nt - 2);
            const char* a1 = cA + (size_t)(t + 1) * kstep;
            const char* a2 = last ? nA : cA + (size_t)(t + 2) * kstep; const char* b2 = last ? nB : cB + (size_t)(t + 2) * kstep;
            const char* a3 = a2 + kstep; const char* b3 = b2 + kstep;
            if (last && has_next) S.a_ready(nxt);
            if constexpr (SP2) {
            PG8_LDB(B0, 0, 0); PG8_LDB(B1, 0, 1); PG8_SCHED; PG8_LDA(At, 0, 0); PG8_STAGE(PG8_SA(1, 1), a1 + hstep, voffA);
            PG8_WAIT_V(8); PG8_WAIT_L(0); PG8_BAR; PG8_MMA(0, 0, At, B0); PG8_MMA(0, 1, At, B1); PG8_BAR; PG8_SCHED;
            PG8_LDA(At, 0, 1); PG8_STAGE(PG8_SB(0, 0), b2, voffB); PG8_STAGE(PG8_SB(0, 1), b2 + hstep, voffB); PG8_STAGE(PG8_SA(0, 0), a2, voffA);
            PG8_WAIT_V(8); PG8_WAIT_L(0); PG8_BAR; PG8_MMA(1, 0, At, B0); PG8_MMA(1, 1, At, B1); PG8_BAR; PG8_SCHED;
            PG8_LDB(B0, 1, 0); PG8_LDB(B1, 1, 1); PG8_SCHED; PG8_LDA(At, 1, 0); PG8_STAGE(PG8_SA(0, 1), a2 + hstep, voffA);
            PG8_WAIT_V(8); PG8_WAIT_L(0); PG8_BAR; PG8_MMA(0, 0, At, B0); PG8_MMA(0, 1, At, B1); PG8_BAR; PG8_SCHED;
            PG8_LDA(At, 1, 1); PG8_STAGE(PG8_SB(1, 0), b3, voffB); PG8_STAGE(PG8_SB(1, 1), b3 + hstep, voffB); PG8_STAGE(PG8_SA(1, 0), a3, voffA);
            PG8_WAIT_V(8); PG8_WAIT_L(0); PG8_BAR; PG8_MMA(1, 0, At, B0); PG8_MMA(1, 1, At, B1); PG8_BAR; PG8_SCHED;
            } else {
            PG8_LDB(B0, 0, 0); PG8_SCHED; PG8_LDA(At, 0, 0); PG8_STAGE(PG8_SA(1, 1), a1 + hstep, voffA);
            PG8_WAIT_L(8); PG8_BAR; PG8_WAIT_L(0); PG8_MMA(0, 0, At, B0); PG8_BAR; PG8_SCHED;
            PG8_LDB(B1, 0, 1); PG8_STAGE(PG8_SB(0, 0), b2, voffB);
            PG8_BAR; PG8_WAIT_L(0); PG8_MMA(0, 1, At, B1); PG8_BAR;
            PG8_LDA(At, 0, 1); PG8_STAGE(PG8_SA(0, 0), a2, voffA);
            PG8_BAR; PG8_WAIT_L(0); PG8_MMA(1, 0, At, B0); PG8_BAR; PG8_SCHED;
            PG8_STAGE(PG8_SB(0, 1), b2 + hstep, voffB);
            PG8_WAIT_V(6); PG8_BAR; PG8_MMA(1, 1, At, B1); PG8_BAR;
            PG8_LDB(B0, 1, 0); PG8_SCHED; PG8_LDA(At, 1, 0); PG8_STAGE(PG8_SA(0, 1), a2 + hstep, voffA);
            PG8_WAIT_L(8); PG8_BAR; PG8_WAIT_L(0); PG8_MMA(0, 0, At, B0); PG8_BAR; PG8_SCHED;
            PG8_LDB(B1, 1, 1); PG8_STAGE(PG8_SB(1, 0), b3, voffB);
            PG8_BAR; PG8_WAIT_L(0); PG8_MMA(0, 1, At, B1); PG8_BAR;
            PG8_LDA(At, 1, 1); PG8_STAGE(PG8_SA(1, 0), a3, voffA);
            PG8_BAR; PG8_WAIT_L(0); PG8_MMA(1, 0, At, B0); PG8_BAR; PG8_SCHED;
            PG8_STAGE(PG8_SB(1, 1), b3 + hstep, voffB);
            PG8_WAIT_V(6); PG8_BAR; PG8_MMA(1, 1, At, B1); PG8_BAR;
            }
        }
        if constexpr (ALIGN_EPI) { if (wr == 0) PG8_BAR; }
        if constexpr (!Epi::AFTER_DRAIN) { E(acc, cur, wr, wc, fr, fq); S.done(cur); }
        if (!has_next) break;
#pragma unroll
        for (int a = 0; a < 2; ++a)
#pragma unroll
            for (int b = 0; b < 2; ++b)
#pragma unroll
                for (int m = 0; m < 4; ++m)
#pragma unroll
                    for (int n = 0; n < 2; ++n) acc[a][b][m][n] = (f32x4){0.f, 0.f, 0.f, 0.f};
        cur = nxt; cA = nA; cB = nB; ++ui;
        if constexpr (ALIGN_EPI) { if (wr == 1) PG8_BAR; }
    }
    PG8_WAIT_V(0);
    if constexpr (!ALIGN_EPI) { if (wr == 0) PG8_BAR; }
    PG8_BAR;
    if constexpr (Epi::AFTER_DRAIN) { E.fused(acc, cur, wr, wc, fr, fq, lds, wid, lane); S.done(cur); }
#undef PG8_SA
#undef PG8_SB
#undef PG8_STAGE
#undef PG8_LDA
#undef PG8_LDB
#undef PG8_MMA
#undef PG8_WAIT_V
#undef PG8_WAIT_L
#undef PG8_BAR
#undef PG8_SCHED
}
}

#ifndef REP_PRO
#define REP_PRO 1
#endif
#ifndef REP_N1
#define REP_N1 1
#endif
#ifndef REP_GU1
#define REP_GU1 1
#endif
#ifndef REP_DN1
#define REP_DN1 1
#endif
#ifndef REP_WIN
#define REP_WIN 1
#endif
#ifndef REP_MIXA
#define REP_MIXA 1
#endif
#ifndef REP_MIXB
#define REP_MIXB 1
#endif
#ifndef MK_N_LAUNCHES
#define MK_N_LAUNCHES 1
#endif

constexpr int NB = 4, SEQ = 2048, DM = 2048, MT = NB * SEQ;
constexpr int DFF = 5632, NMODC = 9 * DM;
constexpr int PW = 1024, HQK = 1024, INW = 5120;
constexpr float EPS = 1e-6f;
constexpr int NPH = 14;
enum { PH_PRO = 0, PH_N1, PH_GU1, PH_DN1, PH_N2, PH_WIN, PH_MIXA, PH_SCAN, PH_MIXB, PH_WOUT, PH_N3, PH_GU2, PH_DN2, PH_FIN };

constexpr size_t MiB = 1u << 20;
constexpr size_t WS_MOD = 0, WS_LB = MiB / 2, WS_BAR = 3 * MiB / 4  , WS_ADEC = 1 * MiB, WS_PWT = 3 * MiB / 2;
constexpr size_t WS_WGU1 = 2 * MiB, WS_WD1 = 46 * MiB, WS_WIN = 68 * MiB, WS_WOUT = 88 * MiB, WS_WGU2 = 96 * MiB, WS_WD2 = 140 * MiB;
constexpr size_t WS_H = 162 * MiB, WS_X = 194 * MiB, WS_MIX = 258 * MiB, WS_HID = 290 * MiB, WS_ST = 290 * MiB  ;
constexpr size_t WS_ZP = 378 * MiB, WS_ZQ = 394 * MiB, WS_ZK = 410 * MiB, WS_ZV = 426 * MiB, WS_ZS = 442 * MiB, WS_ZG = 458 * MiB, WS_END = 490 * MiB;
constexpr int LDS_BYTES = 143360;
constexpr int LDS_MISC = 139264;

#define LAS __attribute__((address_space(3)))
typedef unsigned short bf16_t;
typedef float f32x4 __attribute__((ext_vector_type(4)));
typedef unsigned u32x4 __attribute__((ext_vector_type(4)));
typedef unsigned u32x2 __attribute__((ext_vector_type(2)));
typedef short bf16x8 __attribute__((ext_vector_type(8)));

__device__ __forceinline__ float bf2f(unsigned h) { return __uint_as_float(h << 16); }
__device__ __forceinline__ unsigned pk2(float lo, float hi) { return pg8::cvt_pk_bf16(lo, hi); }
__device__ __forceinline__ float silu_f(float x) { return x * __builtin_amdgcn_rcpf(1.0f + __expf(-x)); }
__device__ __forceinline__ float wave_sum(float v) {
#pragma unroll
    for (int o = 1; o < 64; o <<= 1) v += __shfl_xor(v, o);
    return v;
}

namespace pg8 {
struct EpiSwiglu {
    static constexpr bool PERM = true, AFTER_DRAIN = false;
    bf16_t* O; int ldc;
    __device__ __forceinline__ void operator()(const f32x4 (&acc)[2][2][4][2], const Unit& u, int wr, int wc, int fr, int fq) const {
        const int row0 = u.pm * BM + wr * 64 + fr, col0 = u.pn * HALF + wc * 32 + 8 * fq;
#pragma unroll
        for (int ai = 0; ai < 2; ++ai)
#pragma unroll
            for (int m = 0; m < 4; ++m) {
                bf16_t* rowp = O + (size_t)(row0 + ai * HALF + m * 16) * ldc + col0;
                const f32x4 g0 = acc[ai][0][m][0], g1 = acc[ai][0][m][1], u0 = acc[ai][1][m][0], u1 = acc[ai][1][m][1];
                u32x4 w;
                w.x = cvt_pk_bf16(silu_f(g0[0]) * u0[0], silu_f(g0[1]) * u0[1]); w.y = cvt_pk_bf16(silu_f(g0[2]) * u0[2], silu_f(g0[3]) * u0[3]);
                w.z = cvt_pk_bf16(silu_f(g1[0]) * u1[0], silu_f(g1[1]) * u1[1]); w.w = cvt_pk_bf16(silu_f(g1[2]) * u1[2], silu_f(g1[3]) * u1[3]);
                *(u32x4*)rowp = w;
            }
    }
};
struct EpiResid {
    static constexpr bool PERM = true, AFTER_DRAIN = false;
    const float* Xin; float* Xout; const float* gate; float coef;
    __device__ __forceinline__ void operator()(const f32x4 (&acc)[2][2][4][2], const Unit& u, int wr, int wc, int fr, int fq) const {
        const int row0 = u.pm * BM + wr * 64 + fr, col0 = u.pn * BM + wc * 32 + 8 * fq;
        const float* gp = gate + (size_t)(u.pm >> 3) * NMODC + col0;
        f32x4 gv[2][2];
#pragma unroll
        for (int bj = 0; bj < 2; ++bj)
#pragma unroll
            for (int n = 0; n < 2; ++n) gv[bj][n] = *(const f32x4*)(gp + bj * HALF + 4 * n) * coef;
#pragma unroll
        for (int ai = 0; ai < 2; ++ai)
#pragma unroll
            for (int m = 0; m < 4; ++m) {
                const size_t off = (size_t)(row0 + ai * HALF + m * 16) * DM + col0;
#pragma unroll
                for (int bj = 0; bj < 2; ++bj)
#pragma unroll
                    for (int n = 0; n < 2; ++n) {
                        const f32x4 xi = *(const f32x4*)(Xin + off + bj * HALF + 4 * n);
                        *(f32x4*)(Xout + off + bj * HALF + 4 * n) = xi + gv[bj][n] * acc[ai][bj][m][n];
                    }
                asm volatile("" ::: "memory");
            }
    }
};
struct EpiWin {
    static constexpr bool PERM = true, AFTER_DRAIN = false;
    bf16_t *ZP, *ZQ, *ZK, *ZV, *ZS; float* ZG; const float* lb;
    __device__ __forceinline__ void operator()(const f32x4 (&acc)[2][2][4][2], const Unit& u, int wr, int wc, int fr, int fq) const {
        const int seg = u.pn >> 2;
        const int row0 = u.pm * BM + wr * 64 + fr, col0 = (u.pn & 3) * BM + wc * 32 + 8 * fq;
        bf16_t* O = seg == 0 ? ZP : seg == 1 ? ZQ : seg == 2 ? ZK : seg == 3 ? ZV : ZS;
        if (seg == 2) {
#pragma unroll
            for (int bj = 0; bj < 2; ++bj) {
                const f32x4 l0 = *(const f32x4*)(lb + col0 + bj * HALF), l1 = *(const f32x4*)(lb + col0 + bj * HALF + 4);
#pragma unroll
                for (int ai = 0; ai < 2; ++ai)
#pragma unroll
                    for (int m = 0; m < 4; ++m) {
                        const size_t off = (size_t)(row0 + ai * HALF + m * 16) * HQK + col0 + bj * HALF;
                        float kk[8], gg[8];
#pragma unroll
                        for (int j = 0; j < 8; ++j) {
                            const float z = j < 4 ? acc[ai][bj][m][0][j & 3] : acc[ai][bj][m][1][j & 3];
                            const float lbv = j < 4 ? l0[j & 3] : l1[j & 3];
                            const float e = __expf(-z);
                            const float r = __builtin_amdgcn_rcpf(1.0f + e);
                            const float sg = r, sgc = (e > 3.0e38f) ? 1.0f : e * r;
                            const float forget = lbv + (1.0f - lbv) * sg;
                            kk[j] = (1.0f - lbv) * sgc;
                            gg[j] = logf(forget);
                        }
                        u32x4 w; w.x = cvt_pk_bf16(kk[0], kk[1]); w.y = cvt_pk_bf16(kk[2], kk[3]); w.z = cvt_pk_bf16(kk[4], kk[5]); w.w = cvt_pk_bf16(kk[6], kk[7]);
                        *(u32x4*)(O + off) = w;
                        *(f32x4*)(ZG + off) = (f32x4){gg[0], gg[1], gg[2], gg[3]};
                        *(f32x4*)(ZG + off + 4) = (f32x4){gg[4], gg[5], gg[6], gg[7]};
                    }
            }
        } else {
            const bool act = (seg == 1) || (seg == 4);
#pragma unroll
            for (int ai = 0; ai < 2; ++ai)
#pragma unroll
                for (int m = 0; m < 4; ++m)
#pragma unroll
                    for (int bj = 0; bj < 2; ++bj) {
                        f32x4 v0 = acc[ai][bj][m][0], v1 = acc[ai][bj][m][1];
                        if (act) { v0 = (f32x4){silu_f(v0[0]), silu_f(v0[1]), silu_f(v0[2]), silu_f(v0[3])}; v1 = (f32x4){silu_f(v1[0]), silu_f(v1[1]), silu_f(v1[2]), silu_f(v1[3])}; }
                        u32x4 w; w.x = cvt_pk_bf16(v0[0], v0[1]); w.y = cvt_pk_bf16(v0[2], v0[3]); w.z = cvt_pk_bf16(v1[0], v1[1]); w.w = cvt_pk_bf16(v1[2], v1[3]);
                        *(u32x4*)(O + (size_t)(row0 + ai * HALF + m * 16) * HQK + col0 + bj * HALF) = w;
                    }
        }
    }
};
}

#define XB_TMO      128
#define XB_XCNT(j)  (256  + 64 * (j))
#define XB_XSUB(j)  (1280 + 64 * (j))
#define XB_XGEN(j)  (2304 + 64 * (j))
#define XB_TOP      3328
#define XB_TOPGEN   3392
#define XCD_BAR_WORDS 3456
#define XB_SPIN_CAP (1u << 18)

__device__ __forceinline__ unsigned xb_ld(unsigned* p)              { return __hip_atomic_load(p, __ATOMIC_RELAXED, __HIP_MEMORY_SCOPE_AGENT); }
__device__ __forceinline__ unsigned xb_add(unsigned* p, unsigned v) { return __hip_atomic_fetch_add(p, v, __ATOMIC_RELAXED, __HIP_MEMORY_SCOPE_AGENT); }
__device__ __forceinline__ unsigned xb_xcc_id() { return (unsigned)__builtin_amdgcn_s_getreg((3 << 11) | 20) & 0xFu; }
#define XB_SPIN(cond, bar) do { unsigned _sp = 0; while (cond) { __builtin_amdgcn_s_sleep(1); \
    if ((++_sp & 255u) == 0u) { if (xb_ld(&(bar)[XB_TMO])) break; if (_sp > XB_SPIN_CAP) { atomicAdd(&(bar)[XB_TMO], 1u); break; } } } } while (0)

struct XcdBarrier {
    unsigned* bar; unsigned x;
    volatile LAS unsigned* st;
};

__device__ __forceinline__ XcdBarrier xcd_barrier_post(unsigned* bar, volatile LAS unsigned* st) {
    XcdBarrier b; b.bar = bar; b.x = xb_xcc_id(); b.st = st;
    if (threadIdx.x == 0) (void)xb_add(&bar[XB_XCNT(b.x)], 1u);
    return b;
}
__device__ __forceinline__ void xcd_barrier_complete(unsigned* bar, unsigned x, unsigned& nloc, unsigned& nx) {
    const unsigned G = gridDim.x * gridDim.y * gridDim.z;
    unsigned sum, cnt, mine, sp = 0u;
    for (;;) {
        sum = 0u; cnt = 0u; mine = 0u;
#pragma unroll
        for (unsigned j = 0; j < 16; ++j) { const unsigned c = xb_ld(&bar[XB_XCNT(j)]); sum += c; cnt += (c > 0u) ? 1u : 0u; mine = (j == x) ? c : mine; }
        if (sum == G) break;
        __builtin_amdgcn_s_sleep(1);
        if ((++sp & 255u) == 0u) { if (xb_ld(&bar[XB_TMO])) break; if (sp > XB_SPIN_CAP) { atomicAdd(&bar[XB_TMO], 1u); break; } }
    }
    nloc = mine > 0u ? mine : 1u; nx = cnt > 0u ? cnt : 1u;
}

__device__ __forceinline__ void xcd_barrier(const XcdBarrier& b) {
    asm volatile("s_waitcnt vmcnt(0)" ::: "memory");
    __syncthreads();
    if (threadIdx.x == 0) {
        unsigned* bar = b.bar;
        __builtin_amdgcn_s_waitcnt(0);
        unsigned nloc = b.st[0], nx = b.st[1];
        if (nloc == 0u) { xcd_barrier_complete(bar, b.x, nloc, nx); b.st[0] = nloc; b.st[1] = nx; }
        const unsigned old = xb_add(&bar[XB_XSUB(b.x)], 1u);
        const unsigned gen = old / nloc;
        if (old + 1u == (gen + 1u) * nloc) {
            __builtin_amdgcn_fence(__ATOMIC_RELEASE, "agent");
            asm volatile("s_waitcnt vmcnt(0)" ::: "memory");
            const unsigned og = xb_add(&bar[XB_TOP], 1u);
            const unsigned tg = og / nx;
            if (og + 1u == (tg + 1u) * nx) xb_add(&bar[XB_TOPGEN], 1u);
            else XB_SPIN(xb_ld(&bar[XB_TOPGEN]) == tg, bar);
            __builtin_amdgcn_fence(__ATOMIC_ACQUIRE, "agent");
            xb_add(&bar[XB_XGEN(b.x)], 1u);
            asm volatile("s_waitcnt vmcnt(0)" ::: "memory");
        } else {
            XB_SPIN(xb_ld(&bar[XB_XGEN(b.x)]) == gen, bar);
            __builtin_amdgcn_fence(__ATOMIC_ACQUIRE, "agent");
            asm volatile("s_waitcnt vmcnt(0)" ::: "memory");
        }
    }
    __syncthreads();
}

struct Args { const float* in[20]; float* out; unsigned char* ws; int ph_lo, ph_hi; };

__device__ __forceinline__ void p0_mod(const Args& a, LAS unsigned char* lds, float* mod, int tid, int wave, int lane) {
    LAS float* cact = (LAS float*)lds;
    LAS float* red = (LAS float*)(lds + 32768);
    const float* c = a.in[1];
    for (int i = tid; i < NB * DM; i += 512) { const float v = c[i]; cact[i] = v / (1.0f + __expf(-v)); }
    __syncthreads();
    const float* W = a.in[2]; const float* bias = a.in[3];
    const int cl = lane & 15, kr = lane >> 4;
    for (int slab = blockIdx.x; slab < NMODC / 64; slab += gridDim.x) {
        const int n0 = slab * 64;
        f32x4 acc0 = {0.f, 0.f, 0.f, 0.f}, acc1 = acc0, acc2 = acc0, acc3 = acc0;
        const float* wp = W + (size_t)(wave * 4 + kr) * NMODC + n0 + 4 * cl;
#pragma unroll 8
        for (int i = 0; i < 64; ++i) {
            const int k = i * 32 + wave * 4 + kr;
            const f32x4 wv = *(const f32x4*)(wp + (size_t)i * 32 * NMODC);
            acc0 += cact[k] * wv; acc1 += cact[DM + k] * wv; acc2 += cact[2 * DM + k] * wv; acc3 += cact[3 * DM + k] * wv;
        }
#pragma unroll
        for (int j = 0; j < 4; ++j) {
            acc0[j] += __shfl_xor(acc0[j], 16); acc0[j] += __shfl_xor(acc0[j], 32);
            acc1[j] += __shfl_xor(acc1[j], 16); acc1[j] += __shfl_xor(acc1[j], 32);
            acc2[j] += __shfl_xor(acc2[j], 16); acc2[j] += __shfl_xor(acc2[j], 32);
            acc3[j] += __shfl_xor(acc3[j], 16); acc3[j] += __shfl_xor(acc3[j], 32);
        }
        if (kr == 0) {
            *(LAS f32x4*)(red + (wave * 4 + 0) * 64 + 4 * cl) = acc0; *(LAS f32x4*)(red + (wave * 4 + 1) * 64 + 4 * cl) = acc1;
            *(LAS f32x4*)(red + (wave * 4 + 2) * 64 + 4 * cl) = acc2; *(LAS f32x4*)(red + (wave * 4 + 3) * 64 + 4 * cl) = acc3;
        }
        __syncthreads();
        if (tid < 256) {
            const int b = tid >> 6, col = tid & 63; float s = bias[n0 + col];
#pragma unroll
            for (int w = 0; w < 8; ++w) s += red[(w * 4 + b) * 64 + col];
            mod[(size_t)b * NMODC + n0 + col] = s;
        }
        __syncthreads();
    }
}

__device__ __forceinline__ void transpose_item(const float* W, int K, int N, bf16_t* WT, int mode, int item, int lane) {
    const int nblk = N >> 5, kb = item / nblk, nb = item - kb * nblk, k0 = kb * 64, n0 = nb * 32;
    const int lk = lane >> 3, ln = lane & 7;
    const float* src = W + (size_t)(k0 + 8 * lk) * N + n0 + 4 * ln;
    f32x4 v[8];
#pragma unroll
    for (int i = 0; i < 8; ++i) v[i] = *(const f32x4*)(src + (size_t)i * N);
    const int nn = n0 + 4 * ln;
    const int rowb = mode == 0 ? nn : ((nn >> 7) * 256 + (nn & 127) + (mode == 2 ? 128 : 0));
#pragma unroll
    for (int j = 0; j < 4; ++j) {
        u32x4 o; o.x = pk2(v[0][j], v[1][j]); o.y = pk2(v[2][j], v[3][j]); o.z = pk2(v[4][j], v[5][j]); o.w = pk2(v[6][j], v[7][j]);
        *(u32x4*)(WT + (size_t)(rowb + j) * K + k0 + 8 * lk) = o;
    }
}
__device__ __forceinline__ void p0_weights(const Args& a, unsigned char* ws, int gw, int ngw, int lane) {
    constexpr int I_GU = (DM / 64) * (DFF / 32), I_DN = (DFF / 64) * (DM / 32), I_IN = (DM / 64) * (INW / 32), I_OUT = (DM / 64) * (DM / 32), I_PW = (256 / 64) * (256 / 32);
    constexpr int NITEMS = 4 * I_GU + 2 * I_DN + I_IN + I_OUT + 4 * I_PW;
    for (int it = gw; it < NITEMS; it += ngw) {
        int r = it;
        if (r < I_GU) { transpose_item(a.in[5], DM, DFF, (bf16_t*)(ws + WS_WGU1), 1, r, lane); continue; } r -= I_GU;
        if (r < I_GU) { transpose_item(a.in[6], DM, DFF, (bf16_t*)(ws + WS_WGU1), 2, r, lane); continue; } r -= I_GU;
        if (r < I_DN) { transpose_item(a.in[7], DFF, DM, (bf16_t*)(ws + WS_WD1), 0, r, lane); continue; } r -= I_DN;
        if (r < I_IN) { transpose_item(a.in[9], DM, INW, (bf16_t*)(ws + WS_WIN), 0, r, lane); continue; } r -= I_IN;
        if (r < I_OUT) { transpose_item(a.in[14], DM, DM, (bf16_t*)(ws + WS_WOUT), 0, r, lane); continue; } r -= I_OUT;
        if (r < I_GU) { transpose_item(a.in[16], DM, DFF, (bf16_t*)(ws + WS_WGU2), 1, r, lane); continue; } r -= I_GU;
        if (r < I_GU) { transpose_item(a.in[17], DM, DFF, (bf16_t*)(ws + WS_WGU2), 2, r, lane); continue; } r -= I_GU;
        if (r < I_DN) { transpose_item(a.in[18], DFF, DM, (bf16_t*)(ws + WS_WD2), 0, r, lane); continue; } r -= I_DN;
        const int g = r / I_PW; r -= g * I_PW;
        transpose_item(a.in[10] + (size_t)g * 65536, 256, 256, (bf16_t*)(ws + WS_PWT) + (size_t)g * 65536, 0, r, lane);
    }
}

template <int MODE> __device__ __forceinline__ void norm_phase(const float* X, const float* w, const float* shift, const float* scale, bf16_t* H, float* outp, int gw, int ngw, int lane) {
    for (int row = gw; row < MT; row += ngw) {
        const f32x4* xr = (const f32x4*)(X + (size_t)row * DM) + lane;
        f32x4 v[8]; float ss = 0.f;
#pragma unroll
        for (int j = 0; j < 8; ++j) { v[j] = xr[64 * j]; ss += (v[j][0] * v[j][0] + v[j][1] * v[j][1]) + (v[j][2] * v[j][2] + v[j][3] * v[j][3]); }
        const float r = 1.0f / sqrtf(wave_sum(ss) * (1.0f / DM) + EPS);
        const int b = row >> 11;
#pragma unroll
        for (int j = 0; j < 8; ++j) {
            const int col = 4 * (lane + 64 * j);
            const f32x4 wv = *(const f32x4*)(w + col);
            f32x4 y = v[j] * r * wv;
            if (MODE == 0) {
                const f32x4 sc = *(const f32x4*)(scale + (size_t)b * NMODC + col), sh = *(const f32x4*)(shift + (size_t)b * NMODC + col);
                y = y * (1.0f + sc) + sh;
                u32x2 o; o.x = pk2(y[0], y[1]); o.y = pk2(y[2], y[3]);
                *(u32x2*)(H + (size_t)row * DM + col) = o;
            } else {
                *(f32x4*)(outp + (size_t)row * DM + col) = y;
            }
        }
    }
}

__device__ __forceinline__ void pool_unit(const bf16_t* ZP, const bf16_t* PWT, const float* pscale, bf16_t* MIX, LAS unsigned char* lds, int pu, int tid, int wave, int lane) {
    const int g = pu & 3, rt = pu >> 2, R0 = rt * 64, t0 = R0 & (SEQ - 1), w = 2 << g;
    constexpr int AST = 528;
    LAS unsigned char* U = lds;
    LAS unsigned char* A = lds + 43008;
    const int fr = lane & 15, fq = lane >> 4;
    bf16x8 wf[2][8];
#pragma unroll
    for (int j = 0; j < 2; ++j)
#pragma unroll
        for (int ks = 0; ks < 8; ++ks) wf[j][ks] = *(const bf16x8*)(PWT + (size_t)g * 65536 + (size_t)(32 * wave + 16 * j + fr) * 256 + 32 * ks + 8 * fq);
    {
        const int cl = tid & 31, r = tid >> 5;
        u32x4 v[5];
#pragma unroll
        for (int p = 0; p < 5; ++p) {
            const int j = p * 16 + r;
            v[p] = (u32x4){0u, 0u, 0u, 0u};
            if (t0 - 16 + j >= 0) v[p] = *(const u32x4*)(ZP + (size_t)(R0 - 16 + j) * PW + g * 256 + cl * 8);
        }
#pragma unroll
        for (int p = 0; p < 5; ++p) *(LAS u32x4*)(U + (p * 16 + r) * AST + cl * 16) = v[p];
    }
    __syncthreads();
    {
        const int c = tid & 255, sg = tid >> 8, ts = t0 + sg * 32;
        const LAS unsigned char* up = U + (sg * 32 + 16) * AST + c * 2;
        float win = 0.f;
        for (int j = 1; j < w; ++j) win += bf2f(*(const LAS bf16_t*)(up - j * AST));
#pragma unroll 8
        for (int i = 0; i < 32; ++i) {
            const int t = ts + i;
            const float cur = bf2f(*(const LAS bf16_t*)(up + i * AST));
            win += cur;
            const float cnt = (float)(t + 1 < w ? t + 1 : w);
            const float pooled = win / cnt - cur;
            *(LAS bf16_t*)(A + (sg * 32 + i) * AST + c * 2) = (bf16_t)(pk2(pooled, 0.f) & 0xffffu);
            win -= bf2f(*(const LAS bf16_t*)(up + (i - w + 1) * AST));
        }
    }
    __syncthreads();
#pragma unroll
    for (int tt = 0; tt < 4; ++tt) {
        f32x4 acc[2] = {{0.f, 0.f, 0.f, 0.f}, {0.f, 0.f, 0.f, 0.f}};
#pragma unroll
        for (int ks = 0; ks < 8; ++ks) {
            const bf16x8 bfrag = *(const LAS bf16x8*)(A + (16 * tt + fr) * AST + (32 * ks + 8 * fq) * 2);
#pragma unroll
            for (int j = 0; j < 2; ++j) acc[j] = __builtin_amdgcn_mfma_f32_16x16x32_bf16(wf[j][ks], bfrag, acc[j], 0, 0, 0);
        }
#pragma unroll
        for (int j = 0; j < 2; ++j) {
            const int col = g * 256 + 32 * wave + 16 * j + 4 * fq;
            const f32x4 ps = *(const f32x4*)(pscale + col);
            const f32x4 y = acc[j] * ps;
            u32x2 o; o.x = pk2(y[0], y[1]); o.y = pk2(y[2], y[3]);
            *(u32x2*)(MIX + (size_t)(R0 + 16 * tt + fr) * DM + col) = o;
        }
    }
    __syncthreads();
}

struct HgrnT { const bf16_t *ZQ, *ZK, *ZV, *ZS; const float* ZG; float* ST; float* ADEC; const float* gnorm; bf16_t* MIX; };
template <int PASS> __device__ __forceinline__ void hgrn_unit(const HgrnT& T, LAS unsigned char* lds, int unit, int tid, int wave, int lane) {
    const int c = unit & 31, bh = unit >> 5, h = bh & 7, b = bh >> 3, R0 = b * SEQ + c * 64;
    if (PASS == 1 && c == 31) return;
    const int d = tid & 127, sg = tid >> 7, fr = lane & 15, fq = lane >> 4;
    constexpr int TS = 144, DS = 272;
    LAS float* SEG = (LAS float*)lds;
    LAS unsigned char* QT = lds + 2048;
    LAS unsigned char* KT = lds + 19456;
    LAS unsigned char* VT = lds + 36864;
    LAS unsigned char* SP = lds + 55296;
    LAS unsigned char* AT = lds + 90112;
    LAS float* SSQ = (LAS float*)(lds + 99328);
    const size_t base = (size_t)(R0 + sg * 16) * HQK + h * 128 + d;
    const int tt = wave >> 1, tB = 16 * tt + fr;
    float bb[16]; unsigned vr[16], kr[16], qr[16];
    f32x4 s4[8]; u32x2 zs[4]; f32x4 gwv[4];
#pragma unroll
    for (int i = 0; i < 16; ++i) bb[i] = T.ZG[base + (size_t)i * HQK];
#pragma unroll
    for (int i = 0; i < 16; ++i) kr[i] = T.ZK[base + (size_t)i * HQK];
#pragma unroll
    for (int i = 0; i < 16; ++i) vr[i] = T.ZV[base + (size_t)i * HQK];
    if (PASS == 3) {
#pragma unroll
        for (int i = 0; i < 16; ++i) qr[i] = T.ZQ[base + (size_t)i * HQK];
        const float* sp = T.ST + (size_t)unit * 16384;
#pragma unroll
        for (int j = 0; j < 8; ++j) s4[j] = *(const f32x4*)(sp + (size_t)(tid + 512 * j) * 4);
#pragma unroll
        for (int jj = 0; jj < 4; ++jj) {
            const int v0 = 16 * ((wave & 1) * 4 + jj) + 4 * fq;
            gwv[jj] = *(const f32x4*)(T.gnorm + v0);
            zs[jj] = *(const u32x2*)(T.ZS + (size_t)(R0 + tB) * HQK + h * 128 + v0);
        }
    }
    float run = 0.f;
#pragma unroll
    for (int i = 0; i < 16; ++i) { run += bb[i]; bb[i] = run; }
    SEG[sg * 128 + d] = run;
    {
        *(LAS u32x4*)(VT + d * TS + sg * 32) = (u32x4){vr[0] | (vr[1] << 16), vr[2] | (vr[3] << 16), vr[4] | (vr[5] << 16), vr[6] | (vr[7] << 16)};
        *(LAS u32x4*)(VT + d * TS + sg * 32 + 16) = (u32x4){vr[8] | (vr[9] << 16), vr[10] | (vr[11] << 16), vr[12] | (vr[13] << 16), vr[14] | (vr[15] << 16)};
    }
    if (PASS == 3) {
#pragma unroll
        for (int j = 0; j < 8; ++j) {
            const int idx = tid + 512 * j, v = idx >> 5, d4 = idx & 31;
            u32x2 o; o.x = pk2(s4[j][0], s4[j][1]); o.y = pk2(s4[j][2], s4[j][3]);
            *(LAS u32x2*)(SP + v * DS + d4 * 8) = o;
        }
    }
    __syncthreads();
    float pre = 0.f, tot = 0.f;
#pragma unroll
    for (int s = 0; s < 4; ++s) { const float v = SEG[s * 128 + d]; tot += v; if (s < sg) pre += v; }
#pragma unroll
    for (int i = 0; i < 16; ++i) bb[i] += pre;
    if (PASS == 1) {
        if (sg == 0) T.ADEC[(size_t)unit * 128 + d] = __expf(tot);
        unsigned pkk[8];
#pragma unroll
        for (int i = 0; i < 8; ++i) pkk[i] = pk2(bf2f(kr[2 * i]) * __expf(tot - bb[2 * i]), bf2f(kr[2 * i + 1]) * __expf(tot - bb[2 * i + 1]));
        *(LAS u32x4*)(SP + d * TS + sg * 32) = (u32x4){pkk[0], pkk[1], pkk[2], pkk[3]};
        *(LAS u32x4*)(SP + d * TS + sg * 32 + 16) = (u32x4){pkk[4], pkk[5], pkk[6], pkk[7]};
        __syncthreads();
        bf16x8 bfr[2];
#pragma unroll
        for (int ks = 0; ks < 2; ++ks) bfr[ks] = *(const LAS bf16x8*)(VT + (16 * wave + fr) * TS + (32 * ks + 8 * fq) * 2);
        float* stp = T.ST + (size_t)unit * 16384 + (size_t)(16 * wave + fr) * 128 + 4 * fq;
#pragma unroll
        for (int dt = 0; dt < 8; ++dt) {
            f32x4 acc = {0.f, 0.f, 0.f, 0.f};
#pragma unroll
            for (int ks = 0; ks < 2; ++ks) {
                const bf16x8 afr = *(const LAS bf16x8*)(SP + (16 * dt + fr) * TS + (32 * ks + 8 * fq) * 2);
                acc = __builtin_amdgcn_mfma_f32_16x16x32_bf16(afr, bfr[ks], acc, 0, 0, 0);
            }
            *(f32x4*)(stp + 16 * dt) = acc;
        }
        __syncthreads();
    } else {
#pragma unroll
        for (int i = 0; i < 16; ++i) {
            const float e = __expf(bb[i]);
            const float qt = bf2f(qr[i]) * e;
            const float kt = bf2f(kr[i]) * __builtin_amdgcn_rcpf(e);
            *(LAS bf16_t*)(QT + (sg * 16 + i) * DS + d * 2) = (bf16_t)(pk2(qt, 0.f) & 0xffffu);
            *(LAS bf16_t*)(KT + (sg * 16 + i) * DS + d * 2) = (bf16_t)(pk2(kt, 0.f) & 0xffffu);
        }
        __syncthreads();
        {
#pragma unroll
            for (int jj = 0; jj < 2; ++jj) {
                const int st = (wave & 1) * 2 + jj;
                f32x4 acc = {0.f, 0.f, 0.f, 0.f};
                if (st <= tt) {
#pragma unroll
                    for (int ks = 0; ks < 4; ++ks) {
                        const bf16x8 afr = *(const LAS bf16x8*)(KT + (16 * st + fr) * DS + (32 * ks + 8 * fq) * 2);
                        const bf16x8 bfr = *(const LAS bf16x8*)(QT + tB * DS + (32 * ks + 8 * fq) * 2);
                        acc = __builtin_amdgcn_mfma_f32_16x16x32_bf16(afr, bfr, acc, 0, 0, 0);
                    }
                    const int s0 = 16 * st + 4 * fq;
#pragma unroll
                    for (int r = 0; r < 4; ++r) if (s0 + r > tB) acc[r] = 0.f;
                }
                u32x2 o; o.x = pk2(acc[0], acc[1]); o.y = pk2(acc[2], acc[3]);
                *(LAS u32x2*)(AT + tB * TS + (16 * st + 4 * fq) * 2) = o;
            }
        }
        __syncthreads();
        {
            f32x4 o4[4]; float ssq = 0.f;
            bf16x8 ba[2], bq[4];
#pragma unroll
            for (int ks = 0; ks < 2; ++ks) ba[ks] = *(const LAS bf16x8*)(AT + tB * TS + (32 * ks + 8 * fq) * 2);
#pragma unroll
            for (int ks = 0; ks < 4; ++ks) bq[ks] = *(const LAS bf16x8*)(QT + tB * DS + (32 * ks + 8 * fq) * 2);
#pragma unroll
            for (int jj = 0; jj < 4; ++jj) {
                const int vt = (wave & 1) * 4 + jj;
                f32x4 acc = {0.f, 0.f, 0.f, 0.f};
#pragma unroll
                for (int ks = 0; ks < 2; ++ks) acc = __builtin_amdgcn_mfma_f32_16x16x32_bf16(*(const LAS bf16x8*)(VT + (16 * vt + fr) * TS + (32 * ks + 8 * fq) * 2), ba[ks], acc, 0, 0, 0);
#pragma unroll
                for (int ks = 0; ks < 4; ++ks) acc = __builtin_amdgcn_mfma_f32_16x16x32_bf16(*(const LAS bf16x8*)(SP + (16 * vt + fr) * DS + (32 * ks + 8 * fq) * 2), bq[ks], acc, 0, 0, 0);
                o4[jj] = acc;
                ssq += (acc[0] * acc[0] + acc[1] * acc[1]) + (acc[2] * acc[2] + acc[3] * acc[3]);
            }
            ssq += __shfl_xor(ssq, 16); ssq += __shfl_xor(ssq, 32);
            if (fq == 0) SSQ[(wave & 1) * 64 + tB] = ssq;
            __syncthreads();
            const float rinv = 1.0f / sqrtf((SSQ[tB] + SSQ[64 + tB]) * (1.0f / 128.0f) + EPS);
#pragma unroll
            for (int jj = 0; jj < 4; ++jj) {
                const int v0 = 16 * ((wave & 1) * 4 + jj) + 4 * fq;
                const f32x4 y = o4[jj] * rinv * gwv[jj] * (f32x4){bf2f(zs[jj].x & 0xffffu), bf2f(zs[jj].x >> 16), bf2f(zs[jj].y & 0xffffu), bf2f(zs[jj].y >> 16)};
                u32x2 o; o.x = pk2(y[0], y[1]); o.y = pk2(y[2], y[3]);
                *(u32x2*)(T.MIX + (size_t)(R0 + tB) * DM + PW + h * 128 + v0) = o;
            }
        }
        __syncthreads();
    }
}

__device__ __forceinline__ void scan_phase(float* ST, const float* ADEC, int tid) {
    for (int e = blockIdx.x * 512 + tid; e < 32 * 4096; e += gridDim.x * 512) {
        const int bh = e >> 12, within = e & 4095, d4 = within & 31;
        float* st = ST + (size_t)bh * 32 * 16384 + (size_t)within * 4;
        const float* ad = ADEC + (size_t)bh * 32 * 128 + d4 * 4;
        f32x4 S = {0.f, 0.f, 0.f, 0.f};
        for (int cb = 0; cb < 4; ++cb) {
            f32x4 L[8], A[8];
#pragma unroll
            for (int j = 0; j < 8; ++j) { L[j] = *(const f32x4*)(st + (size_t)(cb * 8 + j) * 16384); A[j] = *(const f32x4*)(ad + (cb * 8 + j) * 128); }
#pragma unroll
            for (int j = 0; j < 8; ++j) { *(f32x4*)(st + (size_t)(cb * 8 + j) * 16384) = S; S = A[j] * S + L[j]; }
        }
    }
}

__global__ void __launch_bounds__(512, 2) fwd_megakernel(Args a) {
    extern __shared__ __attribute__((aligned(16))) unsigned char lds_raw[];
    LAS unsigned char* lds = (LAS unsigned char*)lds_raw;
    cg::grid_group grid = cg::this_grid();
    const int tid = threadIdx.x, lane = tid & 63, wave = __builtin_amdgcn_readfirstlane(tid >> 6);
    const int G = gridDim.x, gw = blockIdx.x * 8 + wave, ngw = G * 8;
    unsigned char* ws = a.ws;
    if (tid < 16) ((LAS unsigned*)(lds + LDS_MISC))[tid] = 0u;
    __syncthreads();
    const XcdBarrier xbar = xcd_barrier_post((unsigned*)(ws + WS_BAR), (volatile LAS unsigned*)(lds + LDS_MISC));
    float* mod = (float*)(ws + WS_MOD); float* lbv = (float*)(ws + WS_LB);
    bf16_t* H = (bf16_t*)(ws + WS_H); float* X = (float*)(ws + WS_X); bf16_t* MIX = (bf16_t*)(ws + WS_MIX); bf16_t* HID = (bf16_t*)(ws + WS_HID);

    const int lo = a.ph_lo, hi = a.ph_hi;
#define IN(k) (lo <= (k) && (k) < hi)
#define SEAM(k) do { if ((k) + 1 < hi) { if ((k) == PH_PRO) grid.sync(); else xcd_barrier(xbar); } } while (0)
    if (IN(PH_PRO)) {
#ifndef SKIP_PRO
      for (int rep = 0; rep < REP_PRO; ++rep) { if (rep) grid.sync();
        p0_mod(a, lds, mod, tid, wave, lane);
        if (blockIdx.x == 0) {
            const float* l = a.in[12];
            for (int j = tid; j < HQK; j += 512) {
                const float l0 = l[j], l1 = l[HQK + j], m = fmaxf(l0, l1), e0 = __expf(l0 - m), e1 = __expf(l1 - m), s = e0 + e1, p0 = e0 / s, p1 = e1 / s;
                lbv[j] = (p0 + p1) - p0;
            }
        }
        p0_weights(a, ws, gw, ngw, lane);
      }
#endif
        SEAM(PH_PRO);
    }
    if (IN(PH_N1)) { for (int rep = 0; rep < REP_N1; ++rep) { if (rep) grid.sync(); norm_phase<0>(a.in[0], a.in[4], mod + 0 * DM, mod + 1 * DM, H, nullptr, gw, ngw, lane); } SEAM(PH_N1); }
    if (IN(PH_GU1)) {
#ifndef SKIP_GU
        pg8::Gemm g{H, (const bf16_t*)(ws + WS_WGU1), MT, 2 * DFF, DM};
        pg8::StaticOrder S; S.init(MT, 2 * DFF, G, (int)blockIdx.x);
        pg8::EpiSwiglu E{HID, DFF};
        for (int rep = 0; rep < REP_GU1; ++rep) { if (rep) grid.sync();
        pg8::gemm_phase<pg8::EpiSwiglu, pg8::StaticOrder, true, true>(lds, g, S, E); }
#endif
        SEAM(PH_GU1);
    }
    if (IN(PH_DN1)) {
#ifndef SKIP_DN
        pg8::Gemm g{HID, (const bf16_t*)(ws + WS_WD1), MT, DM, DFF};
        pg8::StaticOrder S; S.init(MT, DM, G, (int)blockIdx.x);
        pg8::EpiResid E{a.in[0], X, mod + 2 * DM, 0.5f};
        for (int rep = 0; rep < REP_DN1; ++rep) { if (rep) grid.sync();
        pg8::gemm_phase<pg8::EpiResid, pg8::StaticOrder, true, true>(lds, g, S, E); }
#endif
        SEAM(PH_DN1);
    }
    if (IN(PH_N2)) { norm_phase<0>(X, a.in[8], mod + 3 * DM, mod + 4 * DM, H, nullptr, gw, ngw, lane); SEAM(PH_N2); }
    if (IN(PH_WIN)) {
#ifndef SKIP_WIN
        pg8::Gemm g{H, (const bf16_t*)(ws + WS_WIN), MT, INW, DM};
        pg8::StaticOrder S; S.init(MT, INW, G, (int)blockIdx.x);
        pg8::EpiWin E{(bf16_t*)(ws + WS_ZP), (bf16_t*)(ws + WS_ZQ), (bf16_t*)(ws + WS_ZK), (bf16_t*)(ws + WS_ZV), (bf16_t*)(ws + WS_ZS), (float*)(ws + WS_ZG), lbv};
        for (int rep = 0; rep < REP_WIN; ++rep) { if (rep) grid.sync();
        pg8::gemm_phase<pg8::EpiWin, pg8::StaticOrder, true, true>(lds, g, S, E); }
#endif
        SEAM(PH_WIN);
    }
#ifndef SKIP_MIX
    if (IN(PH_MIXA)) {
        HgrnT T{(const bf16_t*)(ws + WS_ZQ), (const bf16_t*)(ws + WS_ZK), (const bf16_t*)(ws + WS_ZV), (const bf16_t*)(ws + WS_ZS), (const float*)(ws + WS_ZG),
                (float*)(ws + WS_ST), (float*)(ws + WS_ADEC), a.in[13], MIX};
        for (int rep = 0; rep < REP_MIXA; ++rep) { if (rep) grid.sync();
        for (int it = blockIdx.x; it < 1024 + 512; it += G) {
            if (it < 1024) hgrn_unit<1>(T, lds, it, tid, wave, lane);
            else pool_unit((const bf16_t*)(ws + WS_ZP), (const bf16_t*)(ws + WS_PWT), a.in[11], MIX, lds, it - 1024, tid, wave, lane);
        } }
        SEAM(PH_MIXA);
    }
    if (IN(PH_SCAN)) { scan_phase((float*)(ws + WS_ST), (const float*)(ws + WS_ADEC), tid); SEAM(PH_SCAN); }
    if (IN(PH_MIXB)) {
        HgrnT T{(const bf16_t*)(ws + WS_ZQ), (const bf16_t*)(ws + WS_ZK), (const bf16_t*)(ws + WS_ZV), (const bf16_t*)(ws + WS_ZS), (const float*)(ws + WS_ZG),
                (float*)(ws + WS_ST), (float*)(ws + WS_ADEC), a.in[13], MIX};
        for (int rep = 0; rep < REP_MIXB; ++rep) { if (rep) grid.sync();
        for (int it = blockIdx.x; it < 1024; it += G) hgrn_unit<3>(T, lds, it, tid, wave, lane); }
        SEAM(PH_MIXB);
    }
#endif
    if (IN(PH_WOUT)) {
#ifndef SKIP_DN
        pg8::Gemm g{MIX, (const bf16_t*)(ws + WS_WOUT), MT, DM, DM};
        pg8::StaticOrder S; S.init(MT, DM, G, (int)blockIdx.x);
        pg8::EpiResid E{X, X, mod + 5 * DM, 1.0f};
        pg8::gemm_phase<pg8::EpiResid, pg8::StaticOrder, true, true>(lds, g, S, E);
#endif
        SEAM(PH_WOUT);
    }
    if (IN(PH_N3)) { norm_phase<0>(X, a.in[15], mod + 6 * DM, mod + 7 * DM, H, nullptr, gw, ngw, lane); SEAM(PH_N3); }
    if (IN(PH_GU2)) {
#ifndef SKIP_GU
        pg8::Gemm g{H, (const bf16_t*)(ws + WS_WGU2), MT, 2 * DFF, DM};
        pg8::StaticOrder S; S.init(MT, 2 * DFF, G, (int)blockIdx.x);
        pg8::EpiSwiglu E{HID, DFF};
        pg8::gemm_phase<pg8::EpiSwiglu, pg8::StaticOrder, true, true>(lds, g, S, E);
#endif
        SEAM(PH_GU2);
    }
    if (IN(PH_DN2)) {
#ifndef SKIP_DN
        pg8::Gemm g{HID, (const bf16_t*)(ws + WS_WD2), MT, DM, DFF};
        pg8::StaticOrder S; S.init(MT, DM, G, (int)blockIdx.x);
        pg8::EpiResid E{X, X, mod + 8 * DM, 0.5f};
        pg8::gemm_phase<pg8::EpiResid, pg8::StaticOrder, true, true>(lds, g, S, E);
#endif
        SEAM(PH_DN2);
    }
    if (IN(PH_FIN)) norm_phase<1>(X, a.in[19], nullptr, nullptr, nullptr, a.out, gw, ngw, lane);
#undef IN
#undef SEAM
}

extern "C" void kernel_launch(void* const* d_in, const int* in_sizes, int n_in, void* d_out, int out_size, void* d_ws, size_t ws_size, hipStream_t stream) {
    static int grid = 0;
    if (grid == 0) {
        if (n_in != 20 || in_sizes[0] != MT * DM || out_size != MT * DM || ws_size < WS_END) {
            fprintf(stderr, "kernel_launch: unexpected problem (n_in %d, in0 %d, out %d, ws %zu); nothing launched\n", n_in, n_in > 0 ? in_sizes[0] : -1, out_size, ws_size); grid = -1; return; }
        int dev = 0, cus = 0, per_cu = 0;
        if (hipGetDevice(&dev) != hipSuccess || hipDeviceGetAttribute(&cus, hipDeviceAttributeMultiprocessorCount, dev) != hipSuccess) { grid = -1; return; }
        if (hipFuncSetAttribute((const void*)fwd_megakernel, hipFuncAttributeMaxDynamicSharedMemorySize, LDS_BYTES) != hipSuccess) { fprintf(stderr, "kernel_launch: hipFuncSetAttribute failed\n"); grid = -1; return; }
        if (hipOccupancyMaxActiveBlocksPerMultiprocessor(&per_cu, (const void*)fwd_megakernel, 512, LDS_BYTES) != hipSuccess || per_cu < 1) { fprintf(stderr, "kernel_launch: occupancy query failed (%d)\n", per_cu); (void)hipGetLastError(); grid = -1; return; }
        grid = cus * per_cu;
    }
    if (grid < 0) return;
    if (hipMemsetAsync((unsigned char*)d_ws + WS_BAR, 0, XCD_BAR_WORDS * 4, stream) != hipSuccess) { fprintf(stderr, "kernel_launch: memset of the barrier words failed\n"); return; }
    Args a{};
    for (int i = 0; i < 20; ++i) a.in[i] = (const float*)d_in[i];
    a.out = (float*)d_out; a.ws = (unsigned char*)d_ws;
    for (int li = 0; li < MK_N_LAUNCHES; ++li) {
        a.ph_lo = (MK_N_LAUNCHES == 1) ? 0 : li; a.ph_hi = (MK_N_LAUNCHES == 1) ? NPH : li + 1;
        void* args[] = {&a};
        const hipError_t e = hipLaunchCooperativeKernel((const void*)fwd_megakernel, dim3(grid), dim3(512), args, LDS_BYTES, stream);
        if (e != hipSuccess) { fprintf(stderr, "kernel_launch: cooperative launch failed: %s (grid %d)\n", hipGetErrorString(e), grid); break; }
    }
}
```

```cpp
#include <hip/hip_runtime.h>
#include <hip/hip_cooperative_groups.h>
#include <cstdio>
#include <cstdint>
namespace cg = cooperative_groups;
namespace pg8 {
#define PG8_LAS __attribute__((address_space(3)))
typedef unsigned short bf16_t;
typedef short bf16x8 __attribute__((ext_vector_type(8)));
typedef float f32x4 __attribute__((ext_vector_type(4)));
typedef unsigned u32x4 __attribute__((ext_vector_type(4)));
constexpr int BM = 256, BK = 64, HALF = 128, HTB = HALF * BK * 2  , STAGE_BYTES = 8 * HTB, NXCD = 8, WGM = 8;

__host__ __device__ __forceinline__ int lds_byte(int r, int c) { const int st = (r >> 4) * 2 + (c >> 5), rr = r & 15, cc = c & 31, ob = rr * 64 + cc * 2; return st * 1024 + (ob ^ (((ob >> 9) & 1) << 5)); }
__host__ __device__ __forceinline__ void stage_rc(int b, int& R, int& C) { const int st = b / 1024, sb = b % 1024, swz = sb ^ (((sb >> 9) & 1) << 5); R = (st >> 1) * 16 + swz / 64; C = (st & 1) * 32 + (swz % 64) / 2; }
__host__ __device__ __forceinline__ int perm32(int rho) { const int n = rho >> 4, i = rho & 15; return 8 * (i >> 2) + 4 * n + (i & 3); }

struct Unit { int pm, pn; };
struct Gemm { const bf16_t* A; const bf16_t* Bt; int M, N, K; };

struct StaticOrder {
    int nM, nN, nwg, G, c;
    __host__ __device__ void init(int M, int N, int G_, int c_) { nM = M / BM; nN = N / BM; nwg = nM * nN; G = G_; c = c_; }
    __host__ __device__ bool next(int i, Unit& u) const {
        const long L = (long)i * G + c; if (L >= nwg) return false;
        int wgid = (int)L; { const int q = nwg / NXCD, r = nwg % NXCD, xcd = wgid % NXCD, off = wgid / NXCD; wgid = (xcd < r ? xcd * (q + 1) : r * (q + 1) + (xcd - r) * q) + off; }
        const int nig = WGM * nN, gid = wgid / nig, fm = gid * WGM, gsz = (nM - fm) < WGM ? (nM - fm) : WGM;
        u.pm = fm + ((wgid % nig) % gsz); u.pn = (wgid % nig) / gsz; return true;
    }
    __device__ __forceinline__ void a_ready(const Unit&) const {}
    __device__ __forceinline__ void done(const Unit&) const {}
};

__device__ __forceinline__ unsigned cvt_pk_bf16(float lo, float hi) { unsigned r; asm volatile("v_cvt_pk_bf16_f32 %0, %1, %2" : "=v"(r) : "v"(lo), "v"(hi)); return r; }
typedef float f32x2 __attribute__((ext_vector_type(2)));
template <class Epi, class Sched, bool ALIGN_EPI = false, bool SP2 = false>
__device__ __forceinline__ void gemm_phase(PG8_LAS unsigned char* lds, const Gemm g, const Sched& S, const Epi& E) {
    const int tid = threadIdx.x, wid = __builtin_amdgcn_readfirstlane(tid >> 6), lane = tid & 63, wr = wid >> 2, wc = wid & 3, fr = lane & 15, fq = lane >> 4;
    const int K = g.K, nt = K / BK;
    unsigned voffA[2], voffB[2];
#pragma unroll
    for (int i = 0; i < 2; ++i) { int R, C; stage_rc(tid * 16 + i * 8192, R, C); const int Rb = Epi::PERM ? ((R & ~31) + perm32(R & 31)) : R;
        voffA[i] = (unsigned)(R * K + C) * 2u; voffB[i] = (unsigned)(Rb * K + C) * 2u; }
    const size_t kstep = (size_t)(BK * 2);
    const size_t hstep = (size_t)HALF * K * 2;
    const size_t tstep = 2 * hstep;
    const unsigned ldsw = (unsigned)wid * 1024u;
    const int aoff = lds_byte(wr * 64 + fr, fq * 8), boff = lds_byte(wc * 32 + fr, fq * 8);
#define PG8_SA(b, h) (((b) * 2 + (h)) * HTB)
#define PG8_SB(b, h) ((4 + (b) * 2 + (h)) * HTB)
#define PG8_STAGE(bufoff, gbase, voff) do { _Pragma("unroll") for (int _i = 0; _i < 2; ++_i) \
        __builtin_amdgcn_global_load_lds((const unsigned*)((const char*)(gbase) + (voff)[_i]), (PG8_LAS unsigned*)(lds + (bufoff) + ldsw + _i * 8192), 16, 0, 0); } while (0)
#define PG8_LDA(dst, b, h) do { _Pragma("unroll") for (int m = 0; m < 4; ++m) _Pragma("unroll") for (int k = 0; k < 2; ++k) dst[m][k] = *(const PG8_LAS bf16x8*)(lds + PG8_SA(b, h) + aoff + m * 2048 + k * 1024); } while (0)
#define PG8_LDB(dst, b, h) do { _Pragma("unroll") for (int n = 0; n < 2; ++n) _Pragma("unroll") for (int k = 0; k < 2; ++k) dst[n][k] = *(const PG8_LAS bf16x8*)(lds + PG8_SB(b, h) + boff + n * 2048 + k * 1024); } while (0)
#define PG8_MMA(ai, bj, At, Bt) do { __builtin_amdgcn_s_setprio(1); _Pragma("unroll") for (int m = 0; m < 4; ++m) _Pragma("unroll") for (int n = 0; n < 2; ++n) _Pragma("unroll") for (int k = 0; k < 2; ++k) \
        acc[ai][bj][m][n] = __builtin_amdgcn_mfma_f32_16x16x32_bf16(Bt[n][k], At[m][k], acc[ai][bj][m][n], 0, 0, 0); __builtin_amdgcn_s_setprio(0); } while (0)
#define PG8_WAIT_V(n) asm volatile("s_waitcnt vmcnt(" #n ")" ::: "memory")
#define PG8_WAIT_L(n) asm volatile("s_waitcnt lgkmcnt(" #n ")" ::: "memory")
#define PG8_BAR __builtin_amdgcn_s_barrier()
#define PG8_SCHED __builtin_amdgcn_sched_barrier(0)
    Unit cur, nxt; int ui = 0;
    if (!S.next(0, cur)) return;
    f32x4 acc[2][2][4][2];
#pragma unroll
    for (int a = 0; a < 2; ++a)
#pragma unroll
        for (int b = 0; b < 2; ++b)
#pragma unroll
            for (int m = 0; m < 4; ++m)
#pragma unroll
                for (int n = 0; n < 2; ++n) acc[a][b][m][n] = (f32x4){0.f, 0.f, 0.f, 0.f};
    bf16x8 At[4][2], B0[2][2], B1[2][2];
    const char* cA = (const char*)g.A + (size_t)cur.pm * tstep; const char* cB = (const char*)g.Bt + (size_t)cur.pn * tstep;
    S.a_ready(cur);
    if constexpr (SP2) {
        PG8_STAGE(PG8_SB(0, 0), cB, voffB); PG8_STAGE(PG8_SB(0, 1), cB + hstep, voffB); PG8_STAGE(PG8_SA(0, 0), cA, voffA); PG8_STAGE(PG8_SA(0, 1), cA + hstep, voffA);
        if (wr == 1) PG8_BAR;
        PG8_WAIT_V(2); PG8_BAR;
        PG8_STAGE(PG8_SB(1, 0), cB + kstep, voffB); PG8_STAGE(PG8_SA(1, 0), cA + kstep, voffA); PG8_STAGE(PG8_SB(1, 1), cB + hstep + kstep, voffB);
        PG8_WAIT_V(6); PG8_BAR;
    } else {
        PG8_STAGE(PG8_SB(0, 0), cB, voffB); PG8_STAGE(PG8_SA(0, 0), cA, voffA); PG8_STAGE(PG8_SB(0, 1), cB + hstep, voffB); PG8_STAGE(PG8_SA(0, 1), cA + hstep, voffA);
        if (wr == 1) PG8_BAR;
        PG8_WAIT_V(4); PG8_BAR;
        PG8_STAGE(PG8_SB(1, 0), cB + kstep, voffB); PG8_STAGE(PG8_SA(1, 0), cA + kstep, voffA); PG8_STAGE(PG8_SB(1, 1), cB + hstep + kstep, voffB);
        PG8_WAIT_V(6); PG8_BAR;
    }
    for (;;) {
        const bool has_next = S.next(ui + 1, nxt);
        const char* nA = has_next ? (const char*)g.A + (size_t)nxt.pm * tstep : cA; const char* nB = has_next ? (const char*)g.Bt + (size_t)nxt.pn * tstep : cB;
        for (int t = 0; t < nt; t += 2) {
            const bool last = (t == nt - 2);
            const char* a1 = cA + (size_t)(t + 1) * kstep;
            const char* a2 = last ? nA : cA + (size_t)(t + 2) * kstep; const char* b2 = last ? nB : cB + (size_t)(t + 2) * kstep;
            const char* a3 = a2 + kstep; const char* b3 = b2 + kstep;
            if (last && has_next) S.a_ready(nxt);
            if constexpr (SP2) {
            PG8_LDB(B0, 0, 0); PG8_LDB(B1, 0, 1); PG8_SCHED; PG8_LDA(At, 0, 0); PG8_STAGE(PG8_SA(1, 1), a1 + hstep, voffA);
            PG8_WAIT_V(8); PG8_WAIT_L(0); PG8_BAR; PG8_MMA(0, 0, At, B0); PG8_MMA(0, 1, At, B1); PG8_BAR; PG8_SCHED;
            PG8_LDA(At, 0, 1); PG8_STAGE(PG8_SB(0, 0), b2, voffB); PG8_STAGE(PG8_SB(0, 1), b2 + hstep, voffB); PG8_STAGE(PG8_SA(0, 0), a2, voffA);
            PG8_WAIT_V(8); PG8_WAIT_L(0); PG8_BAR; PG8_MMA(1, 0, At, B0); PG8_MMA(1, 1, At, B1); PG8_BAR; PG8_SCHED;
            PG8_LDB(B0, 1, 0); PG8_LDB(B1, 1, 1); PG8_SCHED; PG8_LDA(At, 1, 0); PG8_STAGE(PG8_SA(0, 1), a2 + hstep, voffA);
            PG8_WAIT_V(8); PG8_WAIT_L(0); PG8_BAR; PG8_MMA(0, 0, At, B0); PG8_MMA(0, 1, At, B1); PG8_BAR; PG8_SCHED;
            PG8_LDA(At, 1, 1); PG8_STAGE(PG8_SB(1, 0), b3, voffB); PG8_STAGE(PG8_SB(1, 1), b3 + hstep, voffB); PG8_STAGE(PG8_SA(1, 0), a3, voffA);
            PG8_WAIT_V(8); PG8_WAIT_L(0); PG8_BAR; PG8_MMA(1, 0, At, B0); PG8_MMA(1, 1, At, B1); PG8_BAR; PG8_SCHED;
            } else {
            PG8_LDB(B0, 0, 0); PG8_SCHED; PG8_LDA(At, 0, 0); PG8_STAGE(PG8_SA(1, 1), a1 + hstep, voffA);
            PG8_WAIT_L(8); PG8_BAR; PG8_WAIT_L(0); PG8_MMA(0, 0, At, B0); PG8_BAR; PG8_SCHED;
            PG8_LDB(B1, 0, 1); PG8_STAGE(PG8_SB(0, 0), b2, voffB);
            PG8_BAR; PG8_WAIT_L(0); PG8_MMA(0, 1, At, B1); PG8_BAR;
            PG8_LDA(At, 0, 1); PG8_STAGE(PG8_SA(0, 0), a2, voffA);
            PG8_BAR; PG8_WAIT_L(0); PG8_MMA(1, 0, At, B0); PG8_BAR; PG8_SCHED;
            PG8_STAGE(PG8_SB(0, 1), b2 + hstep, voffB);
            PG8_WAIT_V(6); PG8_BAR; PG8_MMA(1, 1, At, B1); PG8_BAR;
            PG8_LDB(B0, 1, 0); PG8_SCHED; PG8_LDA(At, 1, 0); PG8_STAGE(PG8_SA(0, 1), a2 + hstep, voffA);
            PG8_WAIT_L(8); PG8_BAR; PG8_WAIT_L(0); PG8_MMA(0, 0, At, B0); PG8_BAR; PG8_SCHED;
            PG8_LDB(B1, 1, 1); PG8_STAGE(PG8_SB(1, 0), b3, voffB);
            PG8_BAR; PG8_WAIT_L(0); PG8_MMA(0, 1, At, B1); PG8_BAR;
            PG8_LDA(At, 1, 1); PG8_STAGE(PG8_SA(1, 0), a3, voffA);
            PG8_BAR; PG8_WAIT_L(0); PG8_MMA(1, 0, At, B0); PG8_BAR; PG8_SCHED;
            PG8_STAGE(PG8_SB(1, 1), b3 + hstep, voffB);
            PG8_WAIT_V(6); PG8_BAR; PG8_MMA(1, 1, At, B1); PG8_BAR;
            }
        }
        if constexpr (ALIGN_EPI) { if (wr == 0) PG8_BAR; }
        if constexpr (!Epi::AFTER_DRAIN) { E(acc, cur, wr, wc, fr, fq); S.done(cur); }
        if (!has_next) break;
#pragma unroll
        for (int a = 0; a < 2; ++a)
#pragma unroll
            for (int b = 0; b < 2; ++b)
#pragma unroll
                for (int m = 0; m < 4; ++m)
#pragma unroll
                    for (int n = 0; n < 2; ++n) acc[a][b][m][n] = (f32x4){0.f, 0.f, 0.f, 0.f};
        cur = nxt; cA = nA; cB = nB; ++ui;
        if constexpr (ALIGN_EPI) { if (wr == 1) PG8_BAR; }
    }
    PG8_WAIT_V(0);
    if constexpr (!ALIGN_EPI) { if (wr == 0) PG8_BAR; }
    PG8_BAR;
    if constexpr (Epi::AFTER_DRAIN) { E.fused(acc, cur, wr, wc, fr, fq, lds, wid, lane); S.done(cur); }
#undef PG8_SA
#undef PG8_SB
#undef PG8_STAGE
#undef PG8_LDA
#undef PG8_LDB
#undef PG8_MMA
#undef PG8_WAIT_V
#undef PG8_WAIT_L
#undef PG8_BAR
#undef PG8_SCHED
}
}

#ifndef REP_PRO
#define REP_PRO 1
#endif
#ifndef REP_N1
#define REP_N1 1
#endif
#ifndef REP_GU1
#define REP_GU1 1
#endif
#ifndef REP_DN1
#define REP_DN1 1
#endif
#ifndef REP_WIN
#define REP_WIN 1
#endif
#ifndef REP_MIXA
#define REP_MIXA 1
#endif
#ifndef REP_MIXB
#define REP_MIXB 1
#endif
#ifndef MK_N_LAUNCHES
#define MK_N_LAUNCHES 1
#endif

constexpr int NB = 4, SEQ = 2048, DM = 2048, MT = NB * SEQ;
constexpr int DFF = 5632, NMODC = 9 * DM;
constexpr int PW = 1024, HQK = 1024, INW = 5120;
constexpr float EPS = 1e-6f;
constexpr int NPH = 14;
enum { PH_PRO = 0, PH_N1, PH_GU1, PH_DN1, PH_N2, PH_WIN, PH_MIXA, PH_SCAN, PH_MIXB, PH_WOUT, PH_N3, PH_GU2, PH_DN2, PH_FIN };

constexpr size_t MiB = 1u << 20;
constexpr size_t WS_MOD = 0, WS_LB = MiB / 2, WS_BAR = 3 * MiB / 4  , WS_ADEC = 1 * MiB, WS_PWT = 3 * MiB / 2;
constexpr size_t WS_WGU1 = 2 * MiB, WS_WD1 = 46 * MiB, WS_WIN = 68 * MiB, WS_WOUT = 88 * MiB, WS_WGU2 = 96 * MiB, WS_WD2 = 140 * MiB;
constexpr size_t WS_H = 162 * MiB, WS_X = 194 * MiB, WS_MIX = 258 * MiB, WS_HID = 290 * MiB, WS_ST = 290 * MiB  ;
constexpr size_t WS_ZP = 378 * MiB, WS_ZQ = 394 * MiB, WS_ZK = 410 * MiB, WS_ZV = 426 * MiB, WS_ZS = 442 * MiB, WS_ZG = 458 * MiB, WS_END = 490 * MiB;
constexpr int LDS_BYTES = 143360;
constexpr int LDS_MISC = 139264;

#define LAS __attribute__((address_space(3)))
typedef unsigned short bf16_t;
typedef float f32x4 __attribute__((ext_vector_type(4)));
typedef unsigned u32x4 __attribute__((ext_vector_type(4)));
typedef unsigned u32x2 __attribute__((ext_vector_type(2)));
typedef short bf16x8 __attribute__((ext_vector_type(8)));

__device__ __forceinline__ float bf2f(unsigned h) { return __uint_as_float(h << 16); }
__device__ __forceinline__ unsigned pk2(float lo, float hi) { return pg8::cvt_pk_bf16(lo, hi); }
__device__ __forceinline__ float silu_f(float x) { return x * __builtin_amdgcn_rcpf(1.0f + __expf(-x)); }
__device__ __forceinline__ float wave_sum(float v) {
#pragma unroll
    for (int o = 1; o < 64; o <<= 1) v += __shfl_xor(v, o);
    return v;
}

namespace pg8 {
struct EpiSwiglu {
    static constexpr bool PERM = true, AFTER_DRAIN = false;
    bf16_t* O; int ldc;
    __device__ __forceinline__ void operator()(const f32x4 (&acc)[2][2][4][2], const Unit& u, int wr, int wc, int fr, int fq) const {
        const int row0 = u.pm * BM + wr * 64 + fr, col0 = u.pn * HALF + wc * 32 + 8 * fq;
#pragma unroll
        for (int ai = 0; ai < 2; ++ai)
#pragma unroll
            for (int m = 0; m < 4; ++m) {
                bf16_t* rowp = O + (size_t)(row0 + ai * HALF + m * 16) * ldc + col0;
                const f32x4 g0 = acc[ai][0][m][0], g1 = acc[ai][0][m][1], u0 = acc[ai][1][m][0], u1 = acc[ai][1][m][1];
                u32x4 w;
                w.x = cvt_pk_bf16(silu_f(g0[0]) * u0[0], silu_f(g0[1]) * u0[1]); w.y = cvt_pk_bf16(silu_f(g0[2]) * u0[2], silu_f(g0[3]) * u0[3]);
                w.z = cvt_pk_bf16(silu_f(g1[0]) * u1[0], silu_f(g1[1]) * u1[1]); w.w = cvt_pk_bf16(silu_f(g1[2]) * u1[2], silu_f(g1[3]) * u1[3]);
                *(u32x4*)rowp = w;
            }
    }
};
struct EpiResid {
    static constexpr bool PERM = true, AFTER_DRAIN = false;
    const float* Xin; float* Xout; const float* gate; float coef;
    __device__ __forceinline__ void operator()(const f32x4 (&acc)[2][2][4][2], const Unit& u, int wr, int wc, int fr, int fq) const {
        const int row0 = u.pm * BM + wr * 64 + fr, col0 = u.pn * BM + wc * 32 + 8 * fq;
        const float* gp = gate + (size_t)(u.pm >> 3) * NMODC + col0;
        f32x4 gv[2][2];
#pragma unroll
        for (int bj = 0; bj < 2; ++bj)
#pragma unroll
            for (int n = 0; n < 2; ++n) gv[bj][n] = *(const f32x4*)(gp + bj * HALF + 4 * n) * coef;
#pragma unroll
        for (int ai = 0; ai < 2; ++ai)
#pragma unroll
            for (int m = 0; m < 4; ++m) {
                const size_t off = (size_t)(row0 + ai * HALF + m * 16) * DM + col0;
#pragma unroll
                for (int bj = 0; bj < 2; ++bj)
#pragma unroll
                    for (int n = 0; n < 2; ++n) {
                        const f32x4 xi = *(const f32x4*)(Xin + off + bj * HALF + 4 * n);
                        *(f32x4*)(Xout + off + bj * HALF + 4 * n) = xi + gv[bj][n] * acc[ai][bj][m][n];
                    }
                asm volatile("" ::: "memory");
            }
    }
};
struct EpiWin {
    static constexpr bool PERM = true, AFTER_DRAIN = false;
    bf16_t *ZP, *ZQ, *ZK, *ZV, *ZS; float* ZG; const float* lb;
    __device__ __forceinline__ void operator()(const f32x4 (&acc)[2][2][4][2], const Unit& u, int wr, int wc, int fr, int fq) const {
        const int seg = u.pn >> 2;
        const int row0 = u.pm * BM + wr * 64 + fr, col0 = (u.pn & 3) * BM + wc * 32 + 8 * fq;
        bf16_t* O = seg == 0 ? ZP : seg == 1 ? ZQ : seg == 2 ? ZK : seg == 3 ? ZV : ZS;
        if (seg == 2) {
#pragma unroll
            for (int bj = 0; bj < 2; ++bj) {
                const f32x4 l0 = *(const f32x4*)(lb + col0 + bj * HALF), l1 = *(const f32x4*)(lb + col0 + bj * HALF + 4);
#pragma unroll
                for (int ai = 0; ai < 2; ++ai)
#pragma unroll
                    for (int m = 0; m < 4; ++m) {
                        const size_t off = (size_t)(row0 + ai * HALF + m * 16) * HQK + col0 + bj * HALF;
                        float kk[8], gg[8];
#pragma unroll
                        for (int j = 0; j < 8; ++j) {
                            const float z = j < 4 ? acc[ai][bj][m][0][j & 3] : acc[ai][bj][m][1][j & 3];
                            const float lbv = j < 4 ? l0[j & 3] : l1[j & 3];
                            const float e = __expf(-z);
                            const float r = __builtin_amdgcn_rcpf(1.0f + e);
                            const float sg = r, sgc = (e > 3.0e38f) ? 1.0f : e * r;
                            const float forget = lbv + (1.0f - lbv) * sg;
                            kk[j] = (1.0f - lbv) * sgc;
                            gg[j] = logf(forget);
                        }
                        u32x4 w; w.x = cvt_pk_bf16(kk[0], kk[1]); w.y = cvt_pk_bf16(kk[2], kk[3]); w.z = cvt_pk_bf16(kk[4], kk[5]); w.w = cvt_pk_bf16(kk[6], kk[7]);
                        *(u32x4*)(O + off) = w;
                        *(f32x4*)(ZG + off) = (f32x4){gg[0], gg[1], gg[2], gg[3]};
                        *(f32x4*)(ZG + off + 4) = (f32x4){gg[4], gg[5], gg[6], gg[7]};
                    }
            }
        } else {
            const bool act = (seg == 1) || (seg == 4);
#pragma unroll
            for (int ai = 0; ai < 2; ++ai)
#pragma unroll
                for (int m = 0; m < 4; ++m)
#pragma unroll
                    for (int bj = 0; bj < 2; ++bj) {
                        f32x4 v0 = acc[ai][bj][m][0], v1 = acc[ai][bj][m][1];
                        if (act) { v0 = (f32x4){silu_f(v0[0]), silu_f(v0[1]), silu_f(v0[2]), silu_f(v0[3])}; v1 = (f32x4){silu_f(v1[0]), silu_f(v1[1]), silu_f(v1[2]), silu_f(v1[3])}; }
                        u32x4 w; w.x = cvt_pk_bf16(v0[0], v0[1]); w.y = cvt_pk_bf16(v0[2], v0[3]); w.z = cvt_pk_bf16(v1[0], v1[1]); w.w = cvt_pk_bf16(v1[2], v1[3]);
                        *(u32x4*)(O + (size_t)(row0 + ai * HALF + m * 16) * HQK + col0 + bj * HALF) = w;
                    }
        }
    }
};
}

#define XB_TMO      128
#define XB_XCNT(j)  (256  + 64 * (j))
#define XB_XSUB(j)  (1280 + 64 * (j))
#define XB_XGEN(j)  (2304 + 64 * (j))
#define XB_TOP      3328
#define XB_TOPGEN   3392
#define XCD_BAR_WORDS 3456
#define XB_SPIN_CAP (1u << 18)

__device__ __forceinline__ unsigned xb_ld(unsigned* p)              { return __hip_atomic_load(p, __ATOMIC_RELAXED, __HIP_MEMORY_SCOPE_AGENT); }
__device__ __forceinline__ unsigned xb_add(unsigned* p, unsigned v) { return __hip_atomic_fetch_add(p, v, __ATOMIC_RELAXED, __HIP_MEMORY_SCOPE_AGENT); }
__device__ __forceinline__ unsigned xb_xcc_id() { return (unsigned)__builtin_amdgcn_s_getreg((3 << 11) | 20) & 0xFu; }
#define XB_SPIN(cond, bar) do { unsigned _sp = 0; while (cond) { __builtin_amdgcn_s_sleep(1); \
    if ((++_sp & 255u) == 0u) { if (xb_ld(&(bar)[XB_TMO])) break; if (_sp > XB_SPIN_CAP) { atomicAdd(&(bar)[XB_TMO], 1u); break; } } } } while (0)

struct XcdBarrier {
    unsigned* bar; unsigned x;
    volatile LAS unsigned* st;
};

__device__ __forceinline__ XcdBarrier xcd_barrier_post(unsigned* bar, volatile LAS unsigned* st) {
    XcdBarrier b; b.bar = bar; b.x = xb_xcc_id(); b.st = st;
    if (threadIdx.x == 0) (void)xb_add(&bar[XB_XCNT(b.x)], 1u);
    return b;
}
__device__ __forceinline__ void xcd_barrier_complete(unsigned* bar, unsigned x, unsigned& nloc, unsigned& nx) {
    const unsigned G = gridDim.x * gridDim.y * gridDim.z;
    unsigned sum, cnt, mine, sp = 0u;
    for (;;) {
        sum = 0u; cnt = 0u; mine = 0u;
#pragma unroll
        for (unsigned j = 0; j < 16; ++j) { const unsigned c = xb_ld(&bar[XB_XCNT(j)]); sum += c; cnt += (c > 0u) ? 1u : 0u; mine = (j == x) ? c : mine; }
        if (sum == G) break;
        __builtin_amdgcn_s_sleep(1);
        if ((++sp & 255u) == 0u) { if (xb_ld(&bar[XB_TMO])) break; if (sp > XB_SPIN_CAP) { atomicAdd(&bar[XB_TMO], 1u); break; } }
    }
    nloc = mine > 0u ? mine : 1u; nx = cnt > 0u ? cnt : 1u;
}

__device__ __forceinline__ void xcd_barrier(const XcdBarrier& b) {
    asm volatile("s_waitcnt vmcnt(0)" ::: "memory");
    __syncthreads();
    if (threadIdx.x == 0) {
        unsigned* bar = b.bar;
        __builtin_amdgcn_s_waitcnt(0);
        unsigned nloc = b.st[0], nx = b.st[1];
        if (nloc == 0u) { xcd_barrier_complete(bar, b.x, nloc, nx); b.st[0] = nloc; b.st[1] = nx; }
        const unsigned old = xb_add(&bar[XB_XSUB(b.x)], 1u);
        const unsigned gen = old / nloc;
        if (old + 1u == (gen + 1u) * nloc) {
            __builtin_amdgcn_fence(__ATOMIC_RELEASE, "agent");
            asm volatile("s_waitcnt vmcnt(0)" ::: "memory");
            const unsigned og = xb_add(&bar[XB_TOP], 1u);
            const unsigned tg = og / nx;
            if (og + 1u == (tg + 1u) * nx) xb_add(&bar[XB_TOPGEN], 1u);
            else XB_SPIN(xb_ld(&bar[XB_TOPGEN]) == tg, bar);
            __builtin_amdgcn_fence(__ATOMIC_ACQUIRE, "agent");
            xb_add(&bar[XB_XGEN(b.x)], 1u);
            asm volatile("s_waitcnt vmcnt(0)" ::: "memory");
        } else {
            XB_SPIN(xb_ld(&bar[XB_XGEN(b.x)]) == gen, bar);
            __builtin_amdgcn_fence(__ATOMIC_ACQUIRE, "agent");
            asm volatile("s_waitcnt vmcnt(0)" ::: "memory");
        }
    }
    __syncthreads();
}

struct Args { const float* in[20]; float* out; unsigned char* ws; int ph_lo, ph_hi; };

__device__ __forceinline__ void p0_mod(const Args& a, LAS unsigned char* lds, float* mod, int tid, int wave, int lane) {
    LAS float* cact = (LAS float*)lds;
    LAS float* red = (LAS float*)(lds + 32768);
    const float* c = a.in[1];
    for (int i = tid; i < NB * DM; i += 512) { const float v = c[i]; cact[i] = v / (1.0f + __expf(-v)); }
    __syncthreads();
    const float* W = a.in[2]; const float* bias = a.in[3];
    const int cl = lane & 15, kr = lane >> 4;
    for (int slab = blockIdx.x; slab < NMODC / 64; slab += gridDim.x) {
        const int n0 = slab * 64;
        f32x4 acc0 = {0.f, 0.f, 0.f, 0.f}, acc1 = acc0, acc2 = acc0, acc3 = acc0;
        const float* wp = W + (size_t)(wave * 4 + kr) * NMODC + n0 + 4 * cl;
#pragma unroll 16
        for (int i = 0; i < 64; ++i) {
            const int k = i * 32 + wave * 4 + kr;
            const f32x4 wv = *(const f32x4*)(wp + (size_t)i * 32 * NMODC);
            acc0 += cact[k] * wv; acc1 += cact[DM + k] * wv; acc2 += cact[2 * DM + k] * wv; acc3 += cact[3 * DM + k] * wv;
        }
#pragma unroll
        for (int j = 0; j < 4; ++j) {
            acc0[j] += __shfl_xor(acc0[j], 16); acc0[j] += __shfl_xor(acc0[j], 32);
            acc1[j] += __shfl_xor(acc1[j], 16); acc1[j] += __shfl_xor(acc1[j], 32);
            acc2[j] += __shfl_xor(acc2[j], 16); acc2[j] += __shfl_xor(acc2[j], 32);
            acc3[j] += __shfl_xor(acc3[j], 16); acc3[j] += __shfl_xor(acc3[j], 32);
        }
        if (kr == 0) {
            *(LAS f32x4*)(red + (wave * 4 + 0) * 64 + 4 * cl) = acc0; *(LAS f32x4*)(red + (wave * 4 + 1) * 64 + 4 * cl) = acc1;
            *(LAS f32x4*)(red + (wave * 4 + 2) * 64 + 4 * cl) = acc2; *(LAS f32x4*)(red + (wave * 4 + 3) * 64 + 4 * cl) = acc3;
        }
        __syncthreads();
        if (tid < 256) {
            const int b = tid >> 6, col = tid & 63; float s = bias[n0 + col];
#pragma unroll
            for (int w = 0; w < 8; ++w) s += red[(w * 4 + b) * 64 + col];
            mod[(size_t)b * NMODC + n0 + col] = s;
        }
        __syncthreads();
    }
}

__device__ __forceinline__ void transpose_item(const float* W, int K, int N, bf16_t* WT, int mode, int item, int lane) {
    const int nblk = N >> 6, kb = item / nblk, nb = item - kb * nblk, k0 = kb * 64, n0 = nb * 64;
    const int lk = lane >> 3, ln = lane & 7;
    const float* src = W + (size_t)(k0 + 8 * lk) * N + n0 + 4 * ln;
    f32x4 v[2][8];
#pragma unroll
    for (int i = 0; i < 8; ++i)
#pragma unroll
        for (int h = 0; h < 2; ++h) v[h][i] = __builtin_nontemporal_load((const f32x4*)(src + (size_t)i * N + 32 * h));
#pragma unroll
    for (int h = 0; h < 2; ++h) {
        const int nn = n0 + 32 * h + 4 * ln;
        const int rowb = mode == 0 ? nn : ((nn >> 7) * 256 + (nn & 127) + (mode == 2 ? 128 : 0));
#pragma unroll
        for (int j = 0; j < 4; ++j) {
            u32x4 o; o.x = pk2(v[h][0][j], v[h][1][j]); o.y = pk2(v[h][2][j], v[h][3][j]); o.z = pk2(v[h][4][j], v[h][5][j]); o.w = pk2(v[h][6][j], v[h][7][j]);
            *(u32x4*)(WT + (size_t)(rowb + j) * K + k0 + 8 * lk) = o;
        }
    }
}
__device__ __forceinline__ void p0_weights(const Args& a, unsigned char* ws, int gw, int ngw, int lane) {
    constexpr int I_GU = (DM / 64) * (DFF / 64), I_DN = (DFF / 64) * (DM / 64), I_IN = (DM / 64) * (INW / 64), I_OUT = (DM / 64) * (DM / 64), I_PW = (256 / 64) * (256 / 64);
    constexpr int NITEMS = 4 * I_GU + 2 * I_DN + I_IN + I_OUT + 4 * I_PW;
    for (int it = gw; it < NITEMS; it += ngw) {
        int r = it;
        if (r < I_GU) { transpose_item(a.in[5], DM, DFF, (bf16_t*)(ws + WS_WGU1), 1, r, lane); continue; } r -= I_GU;
        if (r < I_GU) { transpose_item(a.in[6], DM, DFF, (bf16_t*)(ws + WS_WGU1), 2, r, lane); continue; } r -= I_GU;
        if (r < I_DN) { transpose_item(a.in[7], DFF, DM, (bf16_t*)(ws + WS_WD1), 0, r, lane); continue; } r -= I_DN;
        if (r < I_IN) { transpose_item(a.in[9], DM, INW, (bf16_t*)(ws + WS_WIN), 0, r, lane); continue; } r -= I_IN;
        if (r < I_OUT) { transpose_item(a.in[14], DM, DM, (bf16_t*)(ws + WS_WOUT), 0, r, lane); continue; } r -= I_OUT;
        if (r < I_GU) { transpose_item(a.in[16], DM, DFF, (bf16_t*)(ws + WS_WGU2), 1, r, lane); continue; } r -= I_GU;
        if (r < I_GU) { transpose_item(a.in[17], DM, DFF, (bf16_t*)(ws + WS_WGU2), 2, r, lane); continue; } r -= I_GU;
        if (r < I_DN) { transpose_item(a.in[18], DFF, DM, (bf16_t*)(ws + WS_WD2), 0, r, lane); continue; } r -= I_DN;
        const int g = r / I_PW; r -= g * I_PW;
        transpose_item(a.in[10] + (size_t)g * 65536, 256, 256, (bf16_t*)(ws + WS_PWT) + (size_t)g * 65536, 0, r, lane);
    }
}

template <int MODE> __device__ __forceinline__ void norm_phase(const float* X, const float* w, const float* shift, const float* scale, bf16_t* H, float* outp, int gw, int ngw, int lane) {
    for (int row = gw; row < MT; row += ngw) {
        const f32x4* xr = (const f32x4*)(X + (size_t)row * DM) + lane;
        f32x4 v[8]; float ss = 0.f;
#pragma unroll
        for (int j = 0; j < 8; ++j) { v[j] = xr[64 * j]; ss += (v[j][0] * v[j][0] + v[j][1] * v[j][1]) + (v[j][2] * v[j][2] + v[j][3] * v[j][3]); }
        const float r = 1.0f / sqrtf(wave_sum(ss) * (1.0f / DM) + EPS);
        const int b = row >> 11;
#pragma unroll
        for (int j = 0; j < 8; ++j) {
            const int col = 4 * (lane + 64 * j);
            const f32x4 wv = *(const f32x4*)(w + col);
            f32x4 y = v[j] * r * wv;
            if (MODE == 0) {
                const f32x4 sc = *(const f32x4*)(scale + (size_t)b * NMODC + col), sh = *(const f32x4*)(shift + (size_t)b * NMODC + col);
                y = y * (1.0f + sc) + sh;
                u32x2 o; o.x = pk2(y[0], y[1]); o.y = pk2(y[2], y[3]);
                *(u32x2*)(H + (size_t)row * DM + col) = o;
            } else {
                *(f32x4*)(outp + (size_t)row * DM + col) = y;
            }
        }
    }
}

__device__ __forceinline__ void pool_unit(const bf16_t* ZP, const bf16_t* PWT, const float* pscale, bf16_t* MIX, LAS unsigned char* lds, int pu, int tid, int wave, int lane) {
    const int g = pu & 3, rt = pu >> 2, R0 = rt * 64, t0 = R0 & (SEQ - 1), w = 2 << g;
    constexpr int AST = 528;
    LAS unsigned char* U = lds;
    LAS unsigned char* A = lds + 43008;
    const int fr = lane & 15, fq = lane >> 4;
    bf16x8 wf[2][8];
#pragma unroll
    for (int j = 0; j < 2; ++j)
#pragma unroll
        for (int ks = 0; ks < 8; ++ks) wf[j][ks] = *(const bf16x8*)(PWT + (size_t)g * 65536 + (size_t)(32 * wave + 16 * j + fr) * 256 + 32 * ks + 8 * fq);
    {
        const int cl = tid & 31, r = tid >> 5;
        u32x4 v[5];
#pragma unroll
        for (int p = 0; p < 5; ++p) {
            const int j = p * 16 + r;
            v[p] = (u32x4){0u, 0u, 0u, 0u};
            if (t0 - 16 + j >= 0) v[p] = *(const u32x4*)(ZP + (size_t)(R0 - 16 + j) * PW + g * 256 + cl * 8);
        }
#pragma unroll
        for (int p = 0; p < 5; ++p) *(LAS u32x4*)(U + (p * 16 + r) * AST + cl * 16) = v[p];
    }
    __syncthreads();
    {
        const int c = tid & 255, sg = tid >> 8, ts = t0 + sg * 32;
        const LAS unsigned char* up = U + (sg * 32 + 16) * AST + c * 2;
        float win = 0.f;
        for (int j = 1; j < w; ++j) win += bf2f(*(const LAS bf16_t*)(up - j * AST));
#pragma unroll 8
        for (int i = 0; i < 32; ++i) {
            const int t = ts + i;
            const float cur = bf2f(*(const LAS bf16_t*)(up + i * AST));
            win += cur;
            const float cnt = (float)(t + 1 < w ? t + 1 : w);
            const float pooled = win / cnt - cur;
            *(LAS bf16_t*)(A + (sg * 32 + i) * AST + c * 2) = (bf16_t)(pk2(pooled, 0.f) & 0xffffu);
            win -= bf2f(*(const LAS bf16_t*)(up + (i - w + 1) * AST));
        }
    }
    __syncthreads();
#pragma unroll
    for (int tt = 0; tt < 4; ++tt) {
        f32x4 acc[2] = {{0.f, 0.f, 0.f, 0.f}, {0.f, 0.f, 0.f, 0.f}};
#pragma unroll
        for (int ks = 0; ks < 8; ++ks) {
            const bf16x8 bfrag = *(const LAS bf16x8*)(A + (16 * tt + fr) * AST + (32 * ks + 8 * fq) * 2);
#pragma unroll
            for (int j = 0; j < 2; ++j) acc[j] = __builtin_amdgcn_mfma_f32_16x16x32_bf16(wf[j][ks], bfrag, acc[j], 0, 0, 0);
        }
#pragma unroll
        for (int j = 0; j < 2; ++j) {
            const int col = g * 256 + 32 * wave + 16 * j + 4 * fq;
            const f32x4 ps = *(const f32x4*)(pscale + col);
            const f32x4 y = acc[j] * ps;
            u32x2 o; o.x = pk2(y[0], y[1]); o.y = pk2(y[2], y[3]);
            *(u32x2*)(MIX + (size_t)(R0 + 16 * tt + fr) * DM + col) = o;
        }
    }
    __syncthreads();
}

struct HgrnT { const bf16_t *ZQ, *ZK, *ZV, *ZS; const float* ZG; float* ST; float* ADEC; const float* gnorm; bf16_t* MIX; };
template <int PASS> __device__ __forceinline__ void hgrn_unit(const HgrnT& T, LAS unsigned char* lds, int unit, int tid, int wave, int lane) {
    const int c = unit & 31, bh = unit >> 5, h = bh & 7, b = bh >> 3, R0 = b * SEQ + c * 64;
    if (PASS == 1 && c == 31) return;
    const int d = tid & 127, sg = tid >> 7, fr = lane & 15, fq = lane >> 4;
    constexpr int TS = 144, DS = 272;
    LAS float* SEG = (LAS float*)lds;
    LAS unsigned char* QT = lds + 2048;
    LAS unsigned char* KT = lds + 19456;
    LAS unsigned char* VT = lds + 36864;
    LAS unsigned char* SP = lds + 55296;
    LAS unsigned char* AT = lds + 90112;
    LAS float* SSQ = (LAS float*)(lds + 99328);
    const size_t base = (size_t)(R0 + sg * 16) * HQK + h * 128 + d;
    const int tt = wave >> 1, tB = 16 * tt + fr;
    float bb[16]; unsigned vr[16], kr[16], qr[16];
    f32x4 s4[8]; u32x2 zs[4]; f32x4 gwv[4];
#pragma unroll
    for (int i = 0; i < 16; ++i) bb[i] = T.ZG[base + (size_t)i * HQK];
#pragma unroll
    for (int i = 0; i < 16; ++i) kr[i] = T.ZK[base + (size_t)i * HQK];
#pragma unroll
    for (int i = 0; i < 16; ++i) vr[i] = T.ZV[base + (size_t)i * HQK];
    if (PASS == 3) {
#pragma unroll
        for (int i = 0; i < 16; ++i) qr[i] = T.ZQ[base + (size_t)i * HQK];
        const float* sp = T.ST + (size_t)unit * 16384;
#pragma unroll
        for (int j = 0; j < 8; ++j) s4[j] = *(const f32x4*)(sp + (size_t)(tid + 512 * j) * 4);
#pragma unroll
        for (int jj = 0; jj < 4; ++jj) {
            const int v0 = 16 * ((wave & 1) * 4 + jj) + 4 * fq;
            gwv[jj] = *(const f32x4*)(T.gnorm + v0);
            zs[jj] = *(const u32x2*)(T.ZS + (size_t)(R0 + tB) * HQK + h * 128 + v0);
        }
    }
    float run = 0.f;
#pragma unroll
    for (int i = 0; i < 16; ++i) { run += bb[i]; bb[i] = run; }
    SEG[sg * 128 + d] = run;
    {
        *(LAS u32x4*)(VT + d * TS + sg * 32) = (u32x4){vr[0] | (vr[1] << 16), vr[2] | (vr[3] << 16), vr[4] | (vr[5] << 16), vr[6] | (vr[7] << 16)};
        *(LAS u32x4*)(VT + d * TS + sg * 32 + 16) = (u32x4){vr[8] | (vr[9] << 16), vr[10] | (vr[11] << 16), vr[12] | (vr[13] << 16), vr[14] | (vr[15] << 16)};
    }
    if (PASS == 3) {
#pragma unroll
        for (int j = 0; j < 8; ++j) {
            const int idx = tid + 512 * j, v = idx >> 5, d4 = idx & 31;
            u32x2 o; o.x = pk2(s4[j][0], s4[j][1]); o.y = pk2(s4[j][2], s4[j][3]);
            *(LAS u32x2*)(SP + v * DS + d4 * 8) = o;
        }
    }
    __syncthreads();
    float pre = 0.f, tot = 0.f;
#pragma unroll
    for (int s = 0; s < 4; ++s) { const float v = SEG[s * 128 + d]; tot += v; if (s < sg) pre += v; }
#pragma unroll
    for (int i = 0; i < 16; ++i) bb[i] += pre;
    if (PASS == 1) {
        if (sg == 0) T.ADEC[(size_t)unit * 128 + d] = __expf(tot);
        unsigned pkk[8];
#pragma unroll
        for (int i = 0; i < 8; ++i) pkk[i] = pk2(bf2f(kr[2 * i]) * __expf(tot - bb[2 * i]), bf2f(kr[2 * i + 1]) * __expf(tot - bb[2 * i + 1]));
        *(LAS u32x4*)(SP + d * TS + sg * 32) = (u32x4){pkk[0], pkk[1], pkk[2], pkk[3]};
        *(LAS u32x4*)(SP + d * TS + sg * 32 + 16) = (u32x4){pkk[4], pkk[5], pkk[6], pkk[7]};
        __syncthreads();
        bf16x8 bfr[2];
#pragma unroll
        for (int ks = 0; ks < 2; ++ks) bfr[ks] = *(const LAS bf16x8*)(VT + (16 * wave + fr) * TS + (32 * ks + 8 * fq) * 2);
        float* stp = T.ST + (size_t)unit * 16384 + (size_t)(16 * wave + fr) * 128 + 4 * fq;
#pragma unroll
        for (int dt = 0; dt < 8; ++dt) {
            f32x4 acc = {0.f, 0.f, 0.f, 0.f};
#pragma unroll
            for (int ks = 0; ks < 2; ++ks) {
                const bf16x8 afr = *(const LAS bf16x8*)(SP + (16 * dt + fr) * TS + (32 * ks + 8 * fq) * 2);
                acc = __builtin_amdgcn_mfma_f32_16x16x32_bf16(afr, bfr[ks], acc, 0, 0, 0);
            }
            *(f32x4*)(stp + 16 * dt) = acc;
        }
        __syncthreads();
    } else {
#pragma unroll
        for (int i = 0; i < 16; ++i) {
            const float e = __expf(bb[i]);
            const float qt = bf2f(qr[i]) * e;
            const float kt = bf2f(kr[i]) * __builtin_amdgcn_rcpf(e);
            *(LAS bf16_t*)(QT + (sg * 16 + i) * DS + d * 2) = (bf16_t)(pk2(qt, 0.f) & 0xffffu);
            *(LAS bf16_t*)(KT + (sg * 16 + i) * DS + d * 2) = (bf16_t)(pk2(kt, 0.f) & 0xffffu);
        }
        __syncthreads();
        {
#pragma unroll
            for (int jj = 0; jj < 2; ++jj) {
                const int st = (wave & 1) * 2 + jj;
                f32x4 acc = {0.f, 0.f, 0.f, 0.f};
                if (st <= tt) {
#pragma unroll
                    for (int ks = 0; ks < 4; ++ks) {
                        const bf16x8 afr = *(const LAS bf16x8*)(KT + (16 * st + fr) * DS + (32 * ks + 8 * fq) * 2);
                        const bf16x8 bfr = *(const LAS bf16x8*)(QT + tB * DS + (32 * ks + 8 * fq) * 2);
                        acc = __builtin_amdgcn_mfma_f32_16x16x32_bf16(afr, bfr, acc, 0, 0, 0);
                    }
                    const int s0 = 16 * st + 4 * fq;
#pragma unroll
                    for (int r = 0; r < 4; ++r) if (s0 + r > tB) acc[r] = 0.f;
                }
                u32x2 o; o.x = pk2(acc[0], acc[1]); o.y = pk2(acc[2], acc[3]);
                *(LAS u32x2*)(AT + tB * TS + (16 * st + 4 * fq) * 2) = o;
            }
        }
        __syncthreads();
        {
            f32x4 o4[4]; float ssq = 0.f;
            bf16x8 ba[2], bq[4];
#pragma unroll
            for (int ks = 0; ks < 2; ++ks) ba[ks] = *(const LAS bf16x8*)(AT + tB * TS + (32 * ks + 8 * fq) * 2);
#pragma unroll
            for (int ks = 0; ks < 4; ++ks) bq[ks] = *(const LAS bf16x8*)(QT + tB * DS + (32 * ks + 8 * fq) * 2);
#pragma unroll
            for (int jj = 0; jj < 4; ++jj) {
                const int vt = (wave & 1) * 4 + jj;
                f32x4 acc = {0.f, 0.f, 0.f, 0.f};
#pragma unroll
                for (int ks = 0; ks < 2; ++ks) acc = __builtin_amdgcn_mfma_f32_16x16x32_bf16(*(const LAS bf16x8*)(VT + (16 * vt + fr) * TS + (32 * ks + 8 * fq) * 2), ba[ks], acc, 0, 0, 0);
#pragma unroll
                for (int ks = 0; ks < 4; ++ks) acc = __builtin_amdgcn_mfma_f32_16x16x32_bf16(*(const LAS bf16x8*)(SP + (16 * vt + fr) * DS + (32 * ks + 8 * fq) * 2), bq[ks], acc, 0, 0, 0);
                o4[jj] = acc;
                ssq += (acc[0] * acc[0] + acc[1] * acc[1]) + (acc[2] * acc[2] + acc[3] * acc[3]);
            }
            ssq += __shfl_xor(ssq, 16); ssq += __shfl_xor(ssq, 32);
            if (fq == 0) SSQ[(wave & 1) * 64 + tB] = ssq;
            __syncthreads();
            const float rinv = 1.0f / sqrtf((SSQ[tB] + SSQ[64 + tB]) * (1.0f / 128.0f) + EPS);
#pragma unroll
            for (int jj = 0; jj < 4; ++jj) {
                const int v0 = 16 * ((wave & 1) * 4 + jj) + 4 * fq;
                const f32x4 y = o4[jj] * rinv * gwv[jj] * (f32x4){bf2f(zs[jj].x & 0xffffu), bf2f(zs[jj].x >> 16), bf2f(zs[jj].y & 0xffffu), bf2f(zs[jj].y >> 16)};
                u32x2 o; o.x = pk2(y[0], y[1]); o.y = pk2(y[2], y[3]);
                *(u32x2*)(T.MIX + (size_t)(R0 + tB) * DM + PW + h * 128 + v0) = o;
            }
        }
        __syncthreads();
    }
}

__device__ __forceinline__ void scan_phase(float* ST, const float* ADEC, int tid) {
    for (int e = blockIdx.x * 512 + tid; e < 32 * 4096; e += gridDim.x * 512) {
        const int bh = e >> 12, within = e & 4095, d4 = within & 31;
        float* st = ST + (size_t)bh * 32 * 16384 + (size_t)within * 4;
        const float* ad = ADEC + (size_t)bh * 32 * 128 + d4 * 4;
        f32x4 S = {0.f, 0.f, 0.f, 0.f};
        for (int cb = 0; cb < 4; ++cb) {
            f32x4 L[8], A[8];
#pragma unroll
            for (int j = 0; j < 8; ++j) { L[j] = *(const f32x4*)(st + (size_t)(cb * 8 + j) * 16384); A[j] = *(const f32x4*)(ad + (cb * 8 + j) * 128); }
#pragma unroll
            for (int j = 0; j < 8; ++j) { *(f32x4*)(st + (size_t)(cb * 8 + j) * 16384) = S; S = A[j] * S + L[j]; }
        }
    }
}

__global__ void __launch_bounds__(512, 2) fwd_megakernel(Args a) {
    extern __shared__ __attribute__((aligned(16))) unsigned char lds_raw[];
    LAS unsigned char* lds = (LAS unsigned char*)lds_raw;
    cg::grid_group grid = cg::this_grid();
    const int tid = threadIdx.x, lane = tid & 63, wave = __builtin_amdgcn_readfirstlane(tid >> 6);
    const int G = gridDim.x, gw = blockIdx.x * 8 + wave, ngw = G * 8;
    unsigned char* ws = a.ws;
    if (tid < 16) ((LAS unsigned*)(lds + LDS_MISC))[tid] = 0u;
    __syncthreads();
    const XcdBarrier xbar = xcd_barrier_post((unsigned*)(ws + WS_BAR), (volatile LAS unsigned*)(lds + LDS_MISC));
    float* mod = (float*)(ws + WS_MOD); float* lbv = (float*)(ws + WS_LB);
    bf16_t* H = (bf16_t*)(ws + WS_H); float* X = (float*)(ws + WS_X); bf16_t* MIX = (bf16_t*)(ws + WS_MIX); bf16_t* HID = (bf16_t*)(ws + WS_HID);

    const int lo = a.ph_lo, hi = a.ph_hi;
#define IN(k) (lo <= (k) && (k) < hi)
#define SEAM(k) do { if ((k) + 1 < hi) xcd_barrier(xbar); } while (0)
    if (hi > NPH) grid.sync();
    if (IN(PH_PRO)) {
#ifndef SKIP_PRO
      for (int rep = 0; rep < REP_PRO; ++rep) { if (rep) grid.sync();
        p0_mod(a, lds, mod, tid, wave, lane);
        if (blockIdx.x == 0) {
            const float* l = a.in[12];
            for (int j = tid; j < HQK; j += 512) {
                const float l0 = l[j], l1 = l[HQK + j], m = fmaxf(l0, l1), e0 = __expf(l0 - m), e1 = __expf(l1 - m), s = e0 + e1, p0 = e0 / s, p1 = e1 / s;
                lbv[j] = (p0 + p1) - p0;
            }
        }
        p0_weights(a, ws, gw, ngw, lane);
      }
#endif
        SEAM(PH_PRO);
    }
    if (IN(PH_N1)) { for (int rep = 0; rep < REP_N1; ++rep) { if (rep) grid.sync(); norm_phase<0>(a.in[0], a.in[4], mod + 0 * DM, mod + 1 * DM, H, nullptr, gw, ngw, lane); } SEAM(PH_N1); }
    if (IN(PH_GU1)) {
#ifndef SKIP_GU
        pg8::Gemm g{H, (const bf16_t*)(ws + WS_WGU1), MT, 2 * DFF, DM};
        pg8::StaticOrder S; S.init(MT, 2 * DFF, G, (int)blockIdx.x);
        pg8::EpiSwiglu E{HID, DFF};
        for (int rep = 0; rep < REP_GU1; ++rep) { if (rep) grid.sync();
        pg8::gemm_phase<pg8::EpiSwiglu, pg8::StaticOrder, true, true>(lds, g, S, E); }
#endif
        SEAM(PH_GU1);
    }
    if (IN(PH_DN1)) {
#ifndef SKIP_DN
        pg8::Gemm g{HID, (const bf16_t*)(ws + WS_WD1), MT, DM, DFF};
        pg8::StaticOrder S; S.init(MT, DM, G, (int)blockIdx.x);
        pg8::EpiResid E{a.in[0], X, mod + 2 * DM, 0.5f};
        for (int rep = 0; rep < REP_DN1; ++rep) { if (rep) grid.sync();
        pg8::gemm_phase<pg8::EpiResid, pg8::StaticOrder, true, true>(lds, g, S, E); }
#endif
        SEAM(PH_DN1);
    }
    if (IN(PH_N2)) { norm_phase<0>(X, a.in[8], mod + 3 * DM, mod + 4 * DM, H, nullptr, gw, ngw, lane); SEAM(PH_N2); }
    if (IN(PH_WIN)) {
#ifndef SKIP_WIN
        pg8::Gemm g{H, (const bf16_t*)(ws + WS_WIN), MT, INW, DM};
        pg8::StaticOrder S; S.init(MT, INW, G, (int)blockIdx.x);
        pg8::EpiWin E{(bf16_t*)(ws + WS_ZP), (bf16_t*)(ws + WS_ZQ), (bf16_t*)(ws + WS_ZK), (bf16_t*)(ws + WS_ZV), (bf16_t*)(ws + WS_ZS), (float*)(ws + WS_ZG), lbv};
        for (int rep = 0; rep < REP_WIN; ++rep) { if (rep) grid.sync();
        pg8::gemm_phase<pg8::EpiWin, pg8::StaticOrder, true, true>(lds, g, S, E); }
#endif
        SEAM(PH_WIN);
    }
#ifndef SKIP_MIX
    if (IN(PH_MIXA)) {
        HgrnT T{(const bf16_t*)(ws + WS_ZQ), (const bf16_t*)(ws + WS_ZK), (const bf16_t*)(ws + WS_ZV), (const bf16_t*)(ws + WS_ZS), (const float*)(ws + WS_ZG),
                (float*)(ws + WS_ST), (float*)(ws + WS_ADEC), a.in[13], MIX};
        for (int rep = 0; rep < REP_MIXA; ++rep) { if (rep) grid.sync();
        for (int it = blockIdx.x; it < 1024 + 512; it += G) {
            if (it < 1024) hgrn_unit<1>(T, lds, it, tid, wave, lane);
            else pool_unit((const bf16_t*)(ws + WS_ZP), (const bf16_t*)(ws + WS_PWT), a.in[11], MIX, lds, it - 1024, tid, wave, lane);
        } }
        SEAM(PH_MIXA);
    }
    if (IN(PH_SCAN)) { scan_phase((float*)(ws + WS_ST), (const float*)(ws + WS_ADEC), tid); SEAM(PH_SCAN); }
    if (IN(PH_MIXB)) {
        HgrnT T{(const bf16_t*)(ws + WS_ZQ), (const bf16_t*)(ws + WS_ZK), (const bf16_t*)(ws + WS_ZV), (const bf16_t*)(ws + WS_ZS), (const float*)(ws + WS_ZG),
                (float*)(ws + WS_ST), (float*)(ws + WS_ADEC), a.in[13], MIX};
        for (int rep = 0; rep < REP_MIXB; ++rep) { if (rep) grid.sync();
        for (int it = blockIdx.x; it < 1024; it += G) hgrn_unit<3>(T, lds, it, tid, wave, lane); }
        SEAM(PH_MIXB);
    }
#endif
    if (IN(PH_WOUT)) {
#ifndef SKIP_DN
        pg8::Gemm g{MIX, (const bf16_t*)(ws + WS_WOUT), MT, DM, DM};
        pg8::StaticOrder S; S.init(MT, DM, G, (int)blockIdx.x);
        pg8::EpiResid E{X, X, mod + 5 * DM, 1.0f};
        pg8::gemm_phase<pg8::EpiResid, pg8::StaticOrder, true, true>(lds, g, S, E);
#endif
        SEAM(PH_WOUT);
    }
    if (IN(PH_N3)) { norm_phase<0>(X, a.in[15], mod + 6 * DM, mod + 7 * DM, H, nullptr, gw, ngw, lane); SEAM(PH_N3); }
    if (IN(PH_GU2)) {
#ifndef SKIP_GU
        pg8::Gemm g{H, (const bf16_t*)(ws + WS_WGU2), MT, 2 * DFF, DM};
        pg8::StaticOrder S; S.init(MT, 2 * DFF, G, (int)blockIdx.x);
        pg8::EpiSwiglu E{HID, DFF};
        pg8::gemm_phase<pg8::EpiSwiglu, pg8::StaticOrder, true, true>(lds, g, S, E);
#endif
        SEAM(PH_GU2);
    }
    if (IN(PH_DN2)) {
#ifndef SKIP_DN
        pg8::Gemm g{HID, (const bf16_t*)(ws + WS_WD2), MT, DM, DFF};
        pg8::StaticOrder S; S.init(MT, DM, G, (int)blockIdx.x);
        pg8::EpiResid E{X, X, mod + 8 * DM, 0.5f};
        pg8::gemm_phase<pg8::EpiResid, pg8::StaticOrder, true, true>(lds, g, S, E);
#endif
        SEAM(PH_DN2);
    }
    if (IN(PH_FIN)) norm_phase<1>(X, a.in[19], nullptr, nullptr, nullptr, a.out, gw, ngw, lane);
#undef IN
#undef SEAM
}

extern "C" void kernel_launch(void* const* d_in, const int* in_sizes, int n_in, void* d_out, int out_size, void* d_ws, size_t ws_size, hipStream_t stream) {
    static int grid = 0;
    if (grid == 0) {
        if (n_in != 20 || in_sizes[0] != MT * DM || out_size != MT * DM || ws_size < WS_END) {
            fprintf(stderr, "kernel_launch: unexpected problem (n_in %d, in0 %d, out %d, ws %zu); nothing launched\n", n_in, n_in > 0 ? in_sizes[0] : -1, out_size, ws_size); grid = -1; return; }
        int dev = 0, cus = 0, per_cu = 0;
        if (hipGetDevice(&dev) != hipSuccess || hipDeviceGetAttribute(&cus, hipDeviceAttributeMultiprocessorCount, dev) != hipSuccess) { grid = -1; return; }
        if (hipFuncSetAttribute((const void*)fwd_megakernel, hipFuncAttributeMaxDynamicSharedMemorySize, LDS_BYTES) != hipSuccess) { fprintf(stderr, "kernel_launch: hipFuncSetAttribute failed\n"); grid = -1; return; }
        if (hipOccupancyMaxActiveBlocksPerMultiprocessor(&per_cu, (const void*)fwd_megakernel, 512, LDS_BYTES) != hipSuccess || per_cu < 1) { fprintf(stderr, "kernel_launch: occupancy query failed (%d)\n", per_cu); (void)hipGetLastError(); grid = -1; return; }
        grid = cus * per_cu;
    }
    if (grid < 0) return;
    if (hipMemsetAsync((unsigned char*)d_ws + WS_BAR, 0, XCD_BAR_WORDS * 4, stream) != hipSuccess) { fprintf(stderr, "kernel_launch: memset of the barrier words failed\n"); return; }
    Args a{};
    for (int i = 0; i < 20; ++i) a.in[i] = (const float*)d_in[i];
    a.out = (float*)d_out; a.ws = (unsigned char*)d_ws;
    for (int li = 0; li < MK_N_LAUNCHES; ++li) {
        a.ph_lo = (MK_N_LAUNCHES == 1) ? 0 : li; a.ph_hi = (MK_N_LAUNCHES == 1) ? NPH : li + 1;
        void* args[] = {&a};
        const hipError_t e = hipLaunchCooperativeKernel((const void*)fwd_megakernel, dim3(grid), dim3(512), args, LDS_BYTES, stream);
        if (e != hipSuccess) { fprintf(stderr, "kernel_launch: cooperative launch failed: %s (grid %d)\n", hipGetErrorString(e), grid); break; }
    }
}
```

```cpp
#include <hip/hip_runtime.h>
#include <hip/hip_cooperative_groups.h>
#include <cstdio>
#include <cstdint>
namespace cg = cooperative_groups;
namespace pg8 {
#define PG8_LAS __attribute__((address_space(3)))
typedef unsigned short bf16_t;
typedef short bf16x8 __attribute__((ext_vector_type(8)));
typedef float f32x4 __attribute__((ext_vector_type(4)));
typedef unsigned u32x4 __attribute__((ext_vector_type(4)));
constexpr int BM = 256, BK = 64, HALF = 128, HTB = HALF * BK * 2  , STAGE_BYTES = 8 * HTB, NXCD = 8, WGM = 8;

__host__ __device__ __forceinline__ int lds_byte(int r, int c) { const int st = (r >> 4) * 2 + (c >> 5), rr = r & 15, cc = c & 31, ob = rr * 64 + cc * 2; return st * 1024 + (ob ^ (((ob >> 9) & 1) << 5)); }
__host__ __device__ __forceinline__ void stage_rc(int b, int& R, int& C) { const int st = b / 1024, sb = b % 1024, swz = sb ^ (((sb >> 9) & 1) << 5); R = (st >> 1) * 16 + swz / 64; C = (st & 1) * 32 + (swz % 64) / 2; }
__host__ __device__ __forceinline__ int perm32(int rho) { const int n = rho >> 4, i = rho & 15; return 8 * (i >> 2) + 4 * n + (i & 3); }

struct Unit { int pm, pn; };
struct Gemm { const bf16_t* A; const bf16_t* Bt; int M, N, K; };

struct StaticOrder {
    int nM, nN, nwg, G, c;
    __host__ __device__ void init(int M, int N, int G_, int c_) { nM = M / BM; nN = N / BM; nwg = nM * nN; G = G_; c = c_; }
    __host__ __device__ bool next(int i, Unit& u) const {
        const long L = (long)i * G + c; if (L >= nwg) return false;
        int wgid = (int)L; { const int q = nwg / NXCD, r = nwg % NXCD, xcd = wgid % NXCD, off = wgid / NXCD; wgid = (xcd < r ? xcd * (q + 1) : r * (q + 1) + (xcd - r) * q) + off; }
        const int nig = WGM * nN, gid = wgid / nig, fm = gid * WGM, gsz = (nM - fm) < WGM ? (nM - fm) : WGM;
        u.pm = fm + ((wgid % nig) % gsz); u.pn = (wgid % nig) / gsz; return true;
    }
    __device__ __forceinline__ void a_ready(const Unit&) const {}
    __device__ __forceinline__ void done(const Unit&) const {}
};

__device__ __forceinline__ unsigned cvt_pk_bf16(float lo, float hi) { unsigned r; asm volatile("v_cvt_pk_bf16_f32 %0, %1, %2" : "=v"(r) : "v"(lo), "v"(hi)); return r; }
typedef float f32x2 __attribute__((ext_vector_type(2)));
template <class Epi, class Sched, bool ALIGN_EPI = false, bool SP2 = false>
__device__ __forceinline__ void gemm_phase(PG8_LAS unsigned char* lds, const Gemm g, const Sched& S, const Epi& E) {
    const int tid = threadIdx.x, wid = __builtin_amdgcn_readfirstlane(tid >> 6), lane = tid & 63, wr = wid >> 2, wc = wid & 3, fr = lane & 15, fq = lane >> 4;
    const int K = g.K, nt = K / BK;
    unsigned voffA[2], voffB[2];
#pragma unroll
    for (int i = 0; i < 2; ++i) { int R, C; stage_rc(tid * 16 + i * 8192, R, C); const int Rb = Epi::PERM ? ((R & ~31) + perm32(R & 31)) : R;
        voffA[i] = (unsigned)(R * K + C) * 2u; voffB[i] = (unsigned)(Rb * K + C) * 2u; }
    const size_t kstep = (size_t)(BK * 2);
    const size_t hstep = (size_t)HALF * K * 2;
    const size_t tstep = 2 * hstep;
    const unsigned ldsw = (unsigned)wid * 1024u;
    const int aoff = lds_byte(wr * 64 + fr, fq * 8), boff = lds_byte(wc * 32 + fr, fq * 8);
#define PG8_SA(b, h) (((b) * 2 + (h)) * HTB)
#define PG8_SB(b, h) ((4 + (b) * 2 + (h)) * HTB)
#define PG8_STAGE(bufoff, gbase, voff) do { _Pragma("unroll") for (int _i = 0; _i < 2; ++_i) \
        __builtin_amdgcn_global_load_lds((const unsigned*)((const char*)(gbase) + (voff)[_i]), (PG8_LAS unsigned*)(lds + (bufoff) + ldsw + _i * 8192), 16, 0, 0); } while (0)
#define PG8_LDA(dst, b, h) do { _Pragma("unroll") for (int m = 0; m < 4; ++m) _Pragma("unroll") for (int k = 0; k < 2; ++k) dst[m][k] = *(const PG8_LAS bf16x8*)(lds + PG8_SA(b, h) + aoff + m * 2048 + k * 1024); } while (0)
#define PG8_LDB(dst, b, h) do { _Pragma("unroll") for (int n = 0; n < 2; ++n) _Pragma("unroll") for (int k = 0; k < 2; ++k) dst[n][k] = *(const PG8_LAS bf16x8*)(lds + PG8_SB(b, h) + boff + n * 2048 + k * 1024); } while (0)
#define PG8_MMA(ai, bj, At, Bt) do { __builtin_amdgcn_s_setprio(1); _Pragma("unroll") for (int m = 0; m < 4; ++m) _Pragma("unroll") for (int n = 0; n < 2; ++n) _Pragma("unroll") for (int k = 0; k < 2; ++k) \
        acc[ai][bj][m][n] = __builtin_amdgcn_mfma_f32_16x16x32_bf16(Bt[n][k], At[m][k], acc[ai][bj][m][n], 0, 0, 0); __builtin_amdgcn_s_setprio(0); } while (0)
#define PG8_WAIT_V(n) asm volatile("s_waitcnt vmcnt(" #n ")" ::: "memory")
#define PG8_WAIT_L(n) asm volatile("s_waitcnt lgkmcnt(" #n ")" ::: "memory")
#define PG8_BAR __builtin_amdgcn_s_barrier()
#define PG8_SCHED __builtin_amdgcn_sched_barrier(0)
    Unit cur, nxt; int ui = 0;
    if (!S.next(0, cur)) return;
    f32x4 acc[2][2][4][2];
#pragma unroll
    for (int a = 0; a < 2; ++a)
#pragma unroll
        for (int b = 0; b < 2; ++b)
#pragma unroll
            for (int m = 0; m < 4; ++m)
#pragma unroll
                for (int n = 0; n < 2; ++n) acc[a][b][m][n] = (f32x4){0.f, 0.f, 0.f, 0.f};
    bf16x8 At[4][2], B0[2][2], B1[2][2];
    const char* cA = (const char*)g.A + (size_t)cur.pm * tstep; const char* cB = (const char*)g.Bt + (size_t)cur.pn * tstep;
    S.a_ready(cur);
    if constexpr (SP2) {
        PG8_STAGE(PG8_SB(0, 0), cB, voffB); PG8_STAGE(PG8_SB(0, 1), cB + hstep, voffB); PG8_STAGE(PG8_SA(0, 0), cA, voffA); PG8_STAGE(PG8_SA(0, 1), cA + hstep, voffA);
        if (wr == 1) PG8_BAR;
        PG8_WAIT_V(2); PG8_BAR;
        PG8_STAGE(PG8_SB(1, 0), cB + kstep, voffB); PG8_STAGE(PG8_SA(1, 0), cA + kstep, voffA); PG8_STAGE(PG8_SB(1, 1), cB + hstep + kstep, voffB);
        PG8_WAIT_V(6); PG8_BAR;
    } else {
        PG8_STAGE(PG8_SB(0, 0), cB, voffB); PG8_STAGE(PG8_SA(0, 0), cA, voffA); PG8_STAGE(PG8_SB(0, 1), cB + hstep, voffB); PG8_STAGE(PG8_SA(0, 1), cA + hstep, voffA);
        if (wr == 1) PG8_BAR;
        PG8_WAIT_V(4); PG8_BAR;
        PG8_STAGE(PG8_SB(1, 0), cB + kstep, voffB); PG8_STAGE(PG8_SA(1, 0), cA + kstep, voffA); PG8_STAGE(PG8_SB(1, 1), cB + hstep + kstep, voffB);
        PG8_WAIT_V(6); PG8_BAR;
    }
    for (;;) {
        const bool has_next = S.next(ui + 1, nxt);
        const char* nA = has_next ? (const char*)g.A + (size_t)nxt.pm * tstep : cA; const char* nB = has_next ? (const char*)g.Bt + (size_t)nxt.pn * tstep : cB;
        for (int t = 0; t < nt; t += 2) {
            const bool last = (t == nt - 2);
            const char* a1 = cA + (size_t)(t + 1) * kstep;
            const char* a2 = last ? nA : cA + (size_t)(t + 2) * kstep; const char* b2 = last ? nB : cB + (size_t)(t + 2) * kstep;
            const char* a3 = a2 + kstep; const char* b3 = b2 + kstep;
            if (last && has_next) S.a_ready(nxt);
            if constexpr (SP2) {
            PG8_LDB(B0, 0, 0); PG8_LDB(B1, 0, 1); PG8_SCHED; PG8_LDA(At, 0, 0); PG8_STAGE(PG8_SA(1, 1), a1 + hstep, voffA);
            PG8_WAIT_V(8); PG8_WAIT_L(0); PG8_BAR; PG8_MMA(0, 0, At, B0); PG8_MMA(0, 1, At, B1); PG8_BAR; PG8_SCHED;
            PG8_LDA(At, 0, 1); PG8_STAGE(PG8_SB(0, 0), b2, voffB); PG8_STAGE(PG8_SB(0, 1), b2 + hstep, voffB); PG8_STAGE(PG8_SA(0, 0), a2, voffA);
            PG8_WAIT_V(8); PG8_WAIT_L(0); PG8_BAR; PG8_MMA(1, 0, At, B0); PG8_MMA(1, 1, At, B1); PG8_BAR; PG8_SCHED;
            PG8_LDB(B0, 1, 0); PG8_LDB(B1, 1, 1); PG8_SCHED; PG8_LDA(At, 1, 0); PG8_STAGE(PG8_SA(0, 1), a2 + hstep, voffA);
            PG8_WAIT_V(8); PG8_WAIT_L(0); PG8_BAR; PG8_MMA(0, 0, At, B0); PG8_MMA(0, 1, At, B1); PG8_BAR; PG8_SCHED;
            PG8_LDA(At, 1, 1); PG8_STAGE(PG8_SB(1, 0), b3, voffB); PG8_STAGE(PG8_SB(1, 1), b3 + hstep, voffB); PG8_STAGE(PG8_SA(1, 0), a3, voffA);
            PG8_WAIT_V(8); PG8_WAIT_L(0); PG8_BAR; PG8_MMA(1, 0, At, B0); PG8_MMA(1, 1, At, B1); PG8_BAR; PG8_SCHED;
            } else {
            PG8_LDB(B0, 0, 0); PG8_SCHED; PG8_LDA(At, 0, 0); PG8_STAGE(PG8_SA(1, 1), a1 + hstep, voffA);
            PG8_WAIT_L(8); PG8_BAR; PG8_WAIT_L(0); PG8_MMA(0, 0, At, B0); PG8_BAR; PG8_SCHED;
            PG8_LDB(B1, 0, 1); PG8_STAGE(PG8_SB(0, 0), b2, voffB);
            PG8_BAR; PG8_WAIT_L(0); PG8_MMA(0, 1, At, B1); PG8_BAR;
            PG8_LDA(At, 0, 1); PG8_STAGE(PG8_SA(0, 0), a2, voffA);
            PG8_BAR; PG8_WAIT_L(0); PG8_MMA(1, 0, At, B0); PG8_BAR; PG8_SCHED;
            PG8_STAGE(PG8_SB(0, 1), b2 + hstep, voffB);
            PG8_WAIT_V(6); PG8_BAR; PG8_MMA(1, 1, At, B1); PG8_BAR;
            PG8_LDB(B0, 1, 0); PG8_SCHED; PG8_LDA(At, 1, 0); PG8_STAGE(PG8_SA(0, 1), a2 + hstep, voffA);
            PG8_WAIT_L(8); PG8_BAR; PG8_WAIT_L(0); PG8_MMA(0, 0, At, B0); PG8_BAR; PG8_SCHED;
            PG8_LDB(B1, 1, 1); PG8_STAGE(PG8_SB(1, 0), b3, voffB);
            PG8_BAR; PG8_WAIT_L(0); PG8_MMA(0, 1, At, B1); PG8_BAR;
            PG8_LDA(At, 1, 1); PG8_STAGE(PG8_SA(1, 0), a3, voffA);
            PG8_BAR; PG8_WAIT_L(0); PG8_MMA(1, 0, At, B0); PG8_BAR; PG8_SCHED;
            PG8_STAGE(PG8_SB(1, 1), b3 + hstep, voffB);
            PG8_WAIT_V(6); PG8_BAR; PG8_MMA(1, 1, At, B1); PG8_BAR;
            }
        }
        if constexpr (ALIGN_EPI) { if (wr == 0) PG8_BAR; }
        if constexpr (!Epi::AFTER_DRAIN) { E(acc, cur, wr, wc, fr, fq); S.done(cur); }
        if (!has_next) break;
#pragma unroll
        for (int a = 0; a < 2; ++a)
#pragma unroll
            for (int b = 0; b < 2; ++b)
#pragma unroll
                for (int m = 0; m < 4; ++m)
#pragma unroll
                    for (int n = 0; n < 2; ++n) acc[a][b][m][n] = (f32x4){0.f, 0.f, 0.f, 0.f};
        cur = nxt; cA = nA; cB = nB; ++ui;
        if constexpr (ALIGN_EPI) { if (wr == 1) PG8_BAR; }
    }
    PG8_WAIT_V(0);
    if constexpr (!ALIGN_EPI) { if (wr == 0) PG8_BAR; }
    PG8_BAR;
    if constexpr (Epi::AFTER_DRAIN) { E.fused(acc, cur, wr, wc, fr, fq, lds, wid, lane); S.done(cur); }
#undef PG8_SA
#undef PG8_SB
#undef PG8_STAGE
#undef PG8_LDA
#undef PG8_LDB
#undef PG8_MMA
#undef PG8_WAIT_V
#undef PG8_WAIT_L
#undef PG8_BAR
#undef PG8_SCHED
}
}

#ifndef REP_PRO
#define REP_PRO 1
#endif
#ifndef REP_N1
#define REP_N1 1
#endif
#ifndef REP_GU1
#define REP_GU1 1
#endif
#ifndef REP_DN1
#define REP_DN1 1
#endif
#ifndef REP_WIN
#define REP_WIN 1
#endif
#ifndef REP_MIXA
#define REP_MIXA 1
#endif
#ifndef REP_MIXB
#define REP_MIXB 1
#endif
#ifndef MK_N_LAUNCHES
#define MK_N_LAUNCHES 1
#endif

constexpr int NB = 4, SEQ = 2048, DM = 2048, MT = NB * SEQ;
constexpr int DFF = 5632, NMODC = 9 * DM;
constexpr int PW = 1024, HQK = 1024, INW = 5120;
constexpr float EPS = 1e-6f;
constexpr int NPH = 14;
enum { PH_PRO = 0, PH_N1, PH_GU1, PH_DN1, PH_N2, PH_WIN, PH_MIXA, PH_SCAN, PH_MIXB, PH_WOUT, PH_N3, PH_GU2, PH_DN2, PH_FIN };

constexpr size_t MiB = 1u << 20;
constexpr size_t WS_MOD = 0, WS_LB = MiB / 2, WS_BAR = 3 * MiB / 4  , WS_ADEC = 1 * MiB, WS_PWT = 3 * MiB / 2;
constexpr size_t WS_WGU1 = 2 * MiB, WS_WD1 = 46 * MiB, WS_WIN = 68 * MiB, WS_WOUT = 88 * MiB, WS_WGU2 = 96 * MiB, WS_WD2 = 140 * MiB;
constexpr size_t WS_H = 162 * MiB, WS_X = 194 * MiB, WS_MIX = 258 * MiB, WS_HID = 290 * MiB, WS_ST = 290 * MiB  ;
constexpr size_t WS_ZP = 378 * MiB, WS_ZQ = 394 * MiB, WS_ZK = 410 * MiB, WS_ZV = 426 * MiB, WS_ZS = 442 * MiB, WS_ZG = 458 * MiB, WS_END = 490 * MiB;
constexpr int LDS_BYTES = 143360;
constexpr int LDS_MISC = 139264;

#define LAS __attribute__((address_space(3)))
typedef unsigned short bf16_t;
typedef float f32x4 __attribute__((ext_vector_type(4)));
typedef unsigned u32x4 __attribute__((ext_vector_type(4)));
typedef unsigned u32x2 __attribute__((ext_vector_type(2)));
typedef short bf16x8 __attribute__((ext_vector_type(8)));

__device__ __forceinline__ float bf2f(unsigned h) { return __uint_as_float(h << 16); }
__device__ __forceinline__ unsigned pk2(float lo, float hi) { return pg8::cvt_pk_bf16(lo, hi); }
__device__ __forceinline__ float silu_f(float x) { return x * __builtin_amdgcn_rcpf(1.0f + __expf(-x)); }
__device__ __forceinline__ float wave_sum(float v) {
#pragma unroll
    for (int o = 1; o < 64; o <<= 1) v += __shfl_xor(v, o);
    return v;
}

namespace pg8 {
struct EpiSwiglu {
    static constexpr bool PERM = true, AFTER_DRAIN = false;
    bf16_t* O; int ldc;
    __device__ __forceinline__ void operator()(const f32x4 (&acc)[2][2][4][2], const Unit& u, int wr, int wc, int fr, int fq) const {
        const int row0 = u.pm * BM + wr * 64 + fr, col0 = u.pn * HALF + wc * 32 + 8 * fq;
#pragma unroll
        for (int ai = 0; ai < 2; ++ai)
#pragma unroll
            for (int m = 0; m < 4; ++m) {
                bf16_t* rowp = O + (size_t)(row0 + ai * HALF + m * 16) * ldc + col0;
                const f32x4 g0 = acc[ai][0][m][0], g1 = acc[ai][0][m][1], u0 = acc[ai][1][m][0], u1 = acc[ai][1][m][1];
                u32x4 w;
                w.x = cvt_pk_bf16(silu_f(g0[0]) * u0[0], silu_f(g0[1]) * u0[1]); w.y = cvt_pk_bf16(silu_f(g0[2]) * u0[2], silu_f(g0[3]) * u0[3]);
                w.z = cvt_pk_bf16(silu_f(g1[0]) * u1[0], silu_f(g1[1]) * u1[1]); w.w = cvt_pk_bf16(silu_f(g1[2]) * u1[2], silu_f(g1[3]) * u1[3]);
                *(u32x4*)rowp = w;
            }
    }
};
struct EpiResid {
    static constexpr bool PERM = true, AFTER_DRAIN = false;
    const float* Xin; float* Xout; const float* gate; float coef;
    __device__ __forceinline__ void operator()(const f32x4 (&acc)[2][2][4][2], const Unit& u, int wr, int wc, int fr, int fq) const {
        const int row0 = u.pm * BM + wr * 64 + fr, col0 = u.pn * BM + wc * 32 + 8 * fq;
        const float* gp = gate + (size_t)(u.pm >> 3) * NMODC + col0;
        f32x4 gv[2][2];
#pragma unroll
        for (int bj = 0; bj < 2; ++bj)
#pragma unroll
            for (int n = 0; n < 2; ++n) gv[bj][n] = *(const f32x4*)(gp + bj * HALF + 4 * n) * coef;
#pragma unroll
        for (int ai = 0; ai < 2; ++ai) {
            f32x4 xi[4][2][2];
#pragma unroll
            for (int m = 0; m < 4; ++m) {
                const size_t off = (size_t)(row0 + ai * HALF + m * 16) * DM + col0;
#pragma unroll
                for (int bj = 0; bj < 2; ++bj)
#pragma unroll
                    for (int n = 0; n < 2; ++n) xi[m][bj][n] = *(const f32x4*)(Xin + off + bj * HALF + 4 * n);
            }
#pragma unroll
            for (int m = 0; m < 4; ++m) {
                const size_t off = (size_t)(row0 + ai * HALF + m * 16) * DM + col0;
#pragma unroll
                for (int bj = 0; bj < 2; ++bj)
#pragma unroll
                    for (int n = 0; n < 2; ++n) *(f32x4*)(Xout + off + bj * HALF + 4 * n) = xi[m][bj][n] + gv[bj][n] * acc[ai][bj][m][n];
            }
            asm volatile("" ::: "memory");
        }
    }
};
struct EpiWin {
    static constexpr bool PERM = true, AFTER_DRAIN = false;
    bf16_t *ZP, *ZQ, *ZK, *ZV, *ZS; float* ZG; const float* lb;
    __device__ __forceinline__ void operator()(const f32x4 (&acc)[2][2][4][2], const Unit& u, int wr, int wc, int fr, int fq) const {
        const int seg = u.pn >> 2;
        const int row0 = u.pm * BM + wr * 64 + fr, col0 = (u.pn & 3) * BM + wc * 32 + 8 * fq;
        bf16_t* O = seg == 0 ? ZP : seg == 1 ? ZQ : seg == 2 ? ZK : seg == 3 ? ZV : ZS;
        if (seg == 2) {
#pragma unroll
            for (int bj = 0; bj < 2; ++bj) {
                const f32x4 l0 = *(const f32x4*)(lb + col0 + bj * HALF), l1 = *(const f32x4*)(lb + col0 + bj * HALF + 4);
#pragma unroll
                for (int ai = 0; ai < 2; ++ai)
#pragma unroll
                    for (int m = 0; m < 4; ++m) {
                        const size_t off = (size_t)(row0 + ai * HALF + m * 16) * HQK + col0 + bj * HALF;
                        float kk[8], gg[8];
#pragma unroll
                        for (int j = 0; j < 8; ++j) {
                            const float z = j < 4 ? acc[ai][bj][m][0][j & 3] : acc[ai][bj][m][1][j & 3];
                            const float lbv = j < 4 ? l0[j & 3] : l1[j & 3];
                            const float e = __expf(-z);
                            const float r = __builtin_amdgcn_rcpf(1.0f + e);
                            const float sg = r, sgc = (e > 3.0e38f) ? 1.0f : e * r;
                            const float forget = lbv + (1.0f - lbv) * sg;
                            kk[j] = (1.0f - lbv) * sgc;
                            gg[j] = logf(forget);
                        }
                        u32x4 w; w.x = cvt_pk_bf16(kk[0], kk[1]); w.y = cvt_pk_bf16(kk[2], kk[3]); w.z = cvt_pk_bf16(kk[4], kk[5]); w.w = cvt_pk_bf16(kk[6], kk[7]);
                        *(u32x4*)(O + off) = w;
                        *(f32x4*)(ZG + off) = (f32x4){gg[0], gg[1], gg[2], gg[3]};
                        *(f32x4*)(ZG + off + 4) = (f32x4){gg[4], gg[5], gg[6], gg[7]};
                    }
            }
        } else {
            const bool act = (seg == 1) || (seg == 4);
#pragma unroll
            for (int ai = 0; ai < 2; ++ai)
#pragma unroll
                for (int m = 0; m < 4; ++m)
#pragma unroll
                    for (int bj = 0; bj < 2; ++bj) {
                        f32x4 v0 = acc[ai][bj][m][0], v1 = acc[ai][bj][m][1];
                        if (act) { v0 = (f32x4){silu_f(v0[0]), silu_f(v0[1]), silu_f(v0[2]), silu_f(v0[3])}; v1 = (f32x4){silu_f(v1[0]), silu_f(v1[1]), silu_f(v1[2]), silu_f(v1[3])}; }
                        u32x4 w; w.x = cvt_pk_bf16(v0[0], v0[1]); w.y = cvt_pk_bf16(v0[2], v0[3]); w.z = cvt_pk_bf16(v1[0], v1[1]); w.w = cvt_pk_bf16(v1[2], v1[3]);
                        *(u32x4*)(O + (size_t)(row0 + ai * HALF + m * 16) * HQK + col0 + bj * HALF) = w;
                    }
        }
    }
};
}

#define XB_TMO      128
#define XB_XCNT(j)  (256  + 64 * (j))
#define XB_XSUB(j)  (1280 + 64 * (j))
#define XB_XGEN(j)  (2304 + 64 * (j))
#define XB_TOP      3328
#define XB_TOPGEN   3392
#define XCD_BAR_WORDS 3456
#define XB_SPIN_CAP (1u << 18)

__device__ __forceinline__ unsigned xb_ld(unsigned* p)              { return __hip_atomic_load(p, __ATOMIC_RELAXED, __HIP_MEMORY_SCOPE_AGENT); }
__device__ __forceinline__ unsigned xb_add(unsigned* p, unsigned v) { return __hip_atomic_fetch_add(p, v, __ATOMIC_RELAXED, __HIP_MEMORY_SCOPE_AGENT); }
__device__ __forceinline__ unsigned xb_xcc_id() { return (unsigned)__builtin_amdgcn_s_getreg((3 << 11) | 20) & 0xFu; }
#define XB_SPIN(cond, bar) do { unsigned _sp = 0; while (cond) { __builtin_amdgcn_s_sleep(1); \
    if ((++_sp & 255u) == 0u) { if (xb_ld(&(bar)[XB_TMO])) break; if (_sp > XB_SPIN_CAP) { atomicAdd(&(bar)[XB_TMO], 1u); break; } } } } while (0)

struct XcdBarrier {
    unsigned* bar; unsigned x;
    volatile LAS unsigned* st;
};

__device__ __forceinline__ XcdBarrier xcd_barrier_post(unsigned* bar, volatile LAS unsigned* st) {
    XcdBarrier b; b.bar = bar; b.x = xb_xcc_id(); b.st = st;
    if (threadIdx.x == 0) (void)xb_add(&bar[XB_XCNT(b.x)], 1u);
    return b;
}
__device__ __forceinline__ void xcd_barrier_complete(unsigned* bar, unsigned x, unsigned& nloc, unsigned& nx) {
    const unsigned G = gridDim.x * gridDim.y * gridDim.z;
    unsigned sum, cnt, mine, sp = 0u;
    for (;;) {
        sum = 0u; cnt = 0u; mine = 0u;
#pragma unroll
        for (unsigned j = 0; j < 16; ++j) { const unsigned c = xb_ld(&bar[XB_XCNT(j)]); sum += c; cnt += (c > 0u) ? 1u : 0u; mine = (j == x) ? c : mine; }
        if (sum == G) break;
        __builtin_amdgcn_s_sleep(1);
        if ((++sp & 255u) == 0u) { if (xb_ld(&bar[XB_TMO])) break; if (sp > XB_SPIN_CAP) { atomicAdd(&bar[XB_TMO], 1u); break; } }
    }
    nloc = mine > 0u ? mine : 1u; nx = cnt > 0u ? cnt : 1u;
}

__device__ __forceinline__ void xcd_barrier(const XcdBarrier& b) {
    asm volatile("s_waitcnt vmcnt(0)" ::: "memory");
    __syncthreads();
    if (threadIdx.x == 0) {
        unsigned* bar = b.bar;
        __builtin_amdgcn_s_waitcnt(0);
        unsigned nloc = b.st[0], nx = b.st[1];
        if (nloc == 0u) { xcd_barrier_complete(bar, b.x, nloc, nx); b.st[0] = nloc; b.st[1] = nx; }
        const unsigned old = xb_add(&bar[XB_XSUB(b.x)], 1u);
        const unsigned gen = old / nloc;
        if (old + 1u == (gen + 1u) * nloc) {
            __builtin_amdgcn_fence(__ATOMIC_RELEASE, "agent");
            asm volatile("s_waitcnt vmcnt(0)" ::: "memory");
            const unsigned og = xb_add(&bar[XB_TOP], 1u);
            const unsigned tg = og / nx;
            if (og + 1u == (tg + 1u) * nx) xb_add(&bar[XB_TOPGEN], 1u);
            else XB_SPIN(xb_ld(&bar[XB_TOPGEN]) == tg, bar);
            __builtin_amdgcn_fence(__ATOMIC_ACQUIRE, "agent");
            xb_add(&bar[XB_XGEN(b.x)], 1u);
            asm volatile("s_waitcnt vmcnt(0)" ::: "memory");
        } else {
            XB_SPIN(xb_ld(&bar[XB_XGEN(b.x)]) == gen, bar);
            __builtin_amdgcn_fence(__ATOMIC_ACQUIRE, "agent");
            asm volatile("s_waitcnt vmcnt(0)" ::: "memory");
        }
    }
    __syncthreads();
}

struct Args { const float* in[20]; float* out; unsigned char* ws; int ph_lo, ph_hi; };

__device__ __forceinline__ void p0_mod(const Args& a, LAS unsigned char* lds, float* mod, int tid, int wave, int lane) {
    LAS float* cact = (LAS float*)lds;
    LAS float* red = (LAS float*)(lds + 32768);
    const float* c = a.in[1];
    for (int i = tid; i < NB * DM; i += 512) { const float v = c[i]; cact[i] = v / (1.0f + __expf(-v)); }
    __syncthreads();
    const float* W = a.in[2]; const float* bias = a.in[3];
    const int cl = lane & 15, kr = lane >> 4;
    for (int slab = blockIdx.x; slab < NMODC / 64; slab += gridDim.x) {
        const int n0 = slab * 64;
        f32x4 acc0 = {0.f, 0.f, 0.f, 0.f}, acc1 = acc0, acc2 = acc0, acc3 = acc0;
        const float* wp = W + (size_t)(wave * 4 + kr) * NMODC + n0 + 4 * cl;
#pragma unroll 16
        for (int i = 0; i < 64; ++i) {
            const int k = i * 32 + wave * 4 + kr;
            const f32x4 wv = *(const f32x4*)(wp + (size_t)i * 32 * NMODC);
            acc0 += cact[k] * wv; acc1 += cact[DM + k] * wv; acc2 += cact[2 * DM + k] * wv; acc3 += cact[3 * DM + k] * wv;
        }
#pragma unroll
        for (int j = 0; j < 4; ++j) {
            acc0[j] += __shfl_xor(acc0[j], 16); acc0[j] += __shfl_xor(acc0[j], 32);
            acc1[j] += __shfl_xor(acc1[j], 16); acc1[j] += __shfl_xor(acc1[j], 32);
            acc2[j] += __shfl_xor(acc2[j], 16); acc2[j] += __shfl_xor(acc2[j], 32);
            acc3[j] += __shfl_xor(acc3[j], 16); acc3[j] += __shfl_xor(acc3[j], 32);
        }
        if (kr == 0) {
            *(LAS f32x4*)(red + (wave * 4 + 0) * 64 + 4 * cl) = acc0; *(LAS f32x4*)(red + (wave * 4 + 1) * 64 + 4 * cl) = acc1;
            *(LAS f32x4*)(red + (wave * 4 + 2) * 64 + 4 * cl) = acc2; *(LAS f32x4*)(red + (wave * 4 + 3) * 64 + 4 * cl) = acc3;
        }
        __syncthreads();
        if (tid < 256) {
            const int b = tid >> 6, col = tid & 63; float s = bias[n0 + col];
#pragma unroll
            for (int w = 0; w < 8; ++w) s += red[(w * 4 + b) * 64 + col];
            mod[(size_t)b * NMODC + n0 + col] = s;
        }
        __syncthreads();
    }
}

__device__ __forceinline__ void transpose_item(const float* W, int K, int N, bf16_t* WT, int mode, int item, int lane) {
    const int nblk = N >> 6, kb = item / nblk, nb = item - kb * nblk, k0 = kb * 64, n0 = nb * 64;
    const int lk = lane >> 3, ln = lane & 7;
    const float* src = W + (size_t)(k0 + 8 * lk) * N + n0 + 4 * ln;
    f32x4 v[2][8];
#pragma unroll
    for (int i = 0; i < 8; ++i)
#pragma unroll
        for (int h = 0; h < 2; ++h) v[h][i] = __builtin_nontemporal_load((const f32x4*)(src + (size_t)i * N + 32 * h));
#pragma unroll
    for (int h = 0; h < 2; ++h) {
        const int nn = n0 + 32 * h + 4 * ln;
        const int rowb = mode == 0 ? nn : ((nn >> 7) * 256 + (nn & 127) + (mode == 2 ? 128 : 0));
#pragma unroll
        for (int j = 0; j < 4; ++j) {
            u32x4 o; o.x = pk2(v[h][0][j], v[h][1][j]); o.y = pk2(v[h][2][j], v[h][3][j]); o.z = pk2(v[h][4][j], v[h][5][j]); o.w = pk2(v[h][6][j], v[h][7][j]);
            *(u32x4*)(WT + (size_t)(rowb + j) * K + k0 + 8 * lk) = o;
        }
    }
}
template <int SET> __device__ __forceinline__ void weight_copies(const Args& a, unsigned char* ws, int widx, int nworkers, int lane) {
    constexpr int I_GU = (DM / 64) * (DFF / 64), I_DN = (DFF / 64) * (DM / 64), I_IN = (DM / 64) * (INW / 64), I_OUT = (DM / 64) * (DM / 64), I_PW = (256 / 64) * (256 / 64);
    constexpr int NITEMS = SET == 0 ? 2 * I_GU : SET == 1 ? I_DN + I_IN + I_OUT + 4 * I_PW : 2 * I_GU + I_DN;
    for (int it = widx; it < NITEMS; it += nworkers) {
        int r = it;
        if (SET == 0) {
            if (r < I_GU) { transpose_item(a.in[5], DM, DFF, (bf16_t*)(ws + WS_WGU1), 1, r, lane); continue; } r -= I_GU;
            transpose_item(a.in[6], DM, DFF, (bf16_t*)(ws + WS_WGU1), 2, r, lane);
        } else if (SET == 1) {
            if (r < I_DN) { transpose_item(a.in[7], DFF, DM, (bf16_t*)(ws + WS_WD1), 0, r, lane); continue; } r -= I_DN;
            if (r < I_IN) { transpose_item(a.in[9], DM, INW, (bf16_t*)(ws + WS_WIN), 0, r, lane); continue; } r -= I_IN;
            if (r < I_OUT) { transpose_item(a.in[14], DM, DM, (bf16_t*)(ws + WS_WOUT), 0, r, lane); continue; } r -= I_OUT;
            const int g = r / I_PW; r -= g * I_PW;
            transpose_item(a.in[10] + (size_t)g * 65536, 256, 256, (bf16_t*)(ws + WS_PWT) + (size_t)g * 65536, 0, r, lane);
        } else {
            if (r < I_GU) { transpose_item(a.in[16], DM, DFF, (bf16_t*)(ws + WS_WGU2), 1, r, lane); continue; } r -= I_GU;
            if (r < I_GU) { transpose_item(a.in[17], DM, DFF, (bf16_t*)(ws + WS_WGU2), 2, r, lane); continue; } r -= I_GU;
            transpose_item(a.in[18], DFF, DM, (bf16_t*)(ws + WS_WD2), 0, r, lane);
        }
    }
}
template <int SET> __device__ __forceinline__ void weight_copies_by_idle(const Args& a, unsigned char* ws, int ntiles, int G, int wave, int lane) {
    const int rem = ntiles % G;
    if (rem == 0) weight_copies<SET>(a, ws, (int)blockIdx.x * 8 + wave, G * 8, lane);
    else if ((int)blockIdx.x >= rem) weight_copies<SET>(a, ws, ((int)blockIdx.x - rem) * 8 + wave, (G - rem) * 8, lane);
}

template <int MODE> __device__ __forceinline__ void norm_phase(const float* X, const float* w, const float* shift, const float* scale, bf16_t* H, float* outp, int gw, int ngw, int lane) {
    for (int row = gw; row < MT; row += ngw) {
        const f32x4* xr = (const f32x4*)(X + (size_t)row * DM) + lane;
        f32x4 v[8]; float ss = 0.f;
#pragma unroll
        for (int j = 0; j < 8; ++j) { v[j] = xr[64 * j]; ss += (v[j][0] * v[j][0] + v[j][1] * v[j][1]) + (v[j][2] * v[j][2] + v[j][3] * v[j][3]); }
        const float r = 1.0f / sqrtf(wave_sum(ss) * (1.0f / DM) + EPS);
        const int b = row >> 11;
#pragma unroll
        for (int j = 0; j < 8; ++j) {
            const int col = 4 * (lane + 64 * j);
            const f32x4 wv = *(const f32x4*)(w + col);
            f32x4 y = v[j] * r * wv;
            if (MODE == 0) {
                const f32x4 sc = *(const f32x4*)(scale + (size_t)b * NMODC + col), sh = *(const f32x4*)(shift + (size_t)b * NMODC + col);
                y = y * (1.0f + sc) + sh;
                u32x2 o; o.x = pk2(y[0], y[1]); o.y = pk2(y[2], y[3]);
                *(u32x2*)(H + (size_t)row * DM + col) = o;
            } else {
                *(f32x4*)(outp + (size_t)row * DM + col) = y;
            }
        }
    }
}

__device__ __forceinline__ void pool_unit(const bf16_t* ZP, const bf16_t* PWT, const float* pscale, bf16_t* MIX, LAS unsigned char* lds, int pu, int tid, int wave, int lane) {
    const int g = pu & 3, rt = pu >> 2, R0 = rt * 64, t0 = R0 & (SEQ - 1), w = 2 << g;
    constexpr int AST = 528;
    LAS unsigned char* U = lds;
    LAS unsigned char* A = lds + 43008;
    const int fr = lane & 15, fq = lane >> 4;
    bf16x8 wf[2][8];
#pragma unroll
    for (int j = 0; j < 2; ++j)
#pragma unroll
        for (int ks = 0; ks < 8; ++ks) wf[j][ks] = *(const bf16x8*)(PWT + (size_t)g * 65536 + (size_t)(32 * wave + 16 * j + fr) * 256 + 32 * ks + 8 * fq);
    {
        const int cl = tid & 31, r = tid >> 5;
        u32x4 v[5];
#pragma unroll
        for (int p = 0; p < 5; ++p) {
            const int j = p * 16 + r;
            v[p] = (u32x4){0u, 0u, 0u, 0u};
            if (t0 - 16 + j >= 0) v[p] = *(const u32x4*)(ZP + (size_t)(R0 - 16 + j) * PW + g * 256 + cl * 8);
        }
#pragma unroll
        for (int p = 0; p < 5; ++p) *(LAS u32x4*)(U + (p * 16 + r) * AST + cl * 16) = v[p];
    }
    __syncthreads();
    {
        const int c = tid & 255, sg = tid >> 8, ts = t0 + sg * 32;
        const LAS unsigned char* up = U + (sg * 32 + 16) * AST + c * 2;
        float win = 0.f;
        for (int j = 1; j < w; ++j) win += bf2f(*(const LAS bf16_t*)(up - j * AST));
#pragma unroll 8
        for (int i = 0; i < 32; ++i) {
            const int t = ts + i;
            const float cur = bf2f(*(const LAS bf16_t*)(up + i * AST));
            win += cur;
            const float cnt = (float)(t + 1 < w ? t + 1 : w);
            const float pooled = win / cnt - cur;
            *(LAS bf16_t*)(A + (sg * 32 + i) * AST + c * 2) = (bf16_t)(pk2(pooled, 0.f) & 0xffffu);
            win -= bf2f(*(const LAS bf16_t*)(up + (i - w + 1) * AST));
        }
    }
    __syncthreads();
#pragma unroll
    for (int tt = 0; tt < 4; ++tt) {
        f32x4 acc[2] = {{0.f, 0.f, 0.f, 0.f}, {0.f, 0.f, 0.f, 0.f}};
#pragma unroll
        for (int ks = 0; ks < 8; ++ks) {
            const bf16x8 bfrag = *(const LAS bf16x8*)(A + (16 * tt + fr) * AST + (32 * ks + 8 * fq) * 2);
#pragma unroll
            for (int j = 0; j < 2; ++j) acc[j] = __builtin_amdgcn_mfma_f32_16x16x32_bf16(wf[j][ks], bfrag, acc[j], 0, 0, 0);
        }
#pragma unroll
        for (int j = 0; j < 2; ++j) {
            const int col = g * 256 + 32 * wave + 16 * j + 4 * fq;
            const f32x4 ps = *(const f32x4*)(pscale + col);
            const f32x4 y = acc[j] * ps;
            u32x2 o; o.x = pk2(y[0], y[1]); o.y = pk2(y[2], y[3]);
            *(u32x2*)(MIX + (size_t)(R0 + 16 * tt + fr) * DM + col) = o;
        }
    }
    __syncthreads();
}

struct HgrnT { const bf16_t *ZQ, *ZK, *ZV, *ZS; const float* ZG; float* ST; float* ADEC; const float* gnorm; bf16_t* MIX; };
template <int PASS> __device__ __forceinline__ void hgrn_unit(const HgrnT& T, LAS unsigned char* lds, int unit, int tid, int wave, int lane) {
    const int c = unit & 31, bh = unit >> 5, h = bh & 7, b = bh >> 3, R0 = b * SEQ + c * 64;
    if (PASS == 1 && c == 31) return;
    const int d = tid & 127, sg = tid >> 7, fr = lane & 15, fq = lane >> 4;
    constexpr int TS = 144, DS = 272;
    LAS float* SEG = (LAS float*)lds;
    LAS unsigned char* QT = lds + 2048;
    LAS unsigned char* KT = lds + 19456;
    LAS unsigned char* VT = lds + 36864;
    LAS unsigned char* SP = lds + 55296;
    LAS unsigned char* AT = lds + 90112;
    LAS float* SSQ = (LAS float*)(lds + 99328);
    const size_t base = (size_t)(R0 + sg * 16) * HQK + h * 128 + d;
    const int tt = wave >> 1, tB = 16 * tt + fr;
    float bb[16]; unsigned vr[16], kr[16], qr[16];
    f32x4 s4[8]; u32x2 zs[4]; f32x4 gwv[4];
#pragma unroll
    for (int i = 0; i < 16; ++i) bb[i] = T.ZG[base + (size_t)i * HQK];
#pragma unroll
    for (int i = 0; i < 16; ++i) kr[i] = T.ZK[base + (size_t)i * HQK];
#pragma unroll
    for (int i = 0; i < 16; ++i) vr[i] = T.ZV[base + (size_t)i * HQK];
    if (PASS == 3) {
#pragma unroll
        for (int i = 0; i < 16; ++i) qr[i] = T.ZQ[base + (size_t)i * HQK];
        const float* sp = T.ST + (size_t)unit * 16384;
#pragma unroll
        for (int j = 0; j < 8; ++j) s4[j] = *(const f32x4*)(sp + (size_t)(tid + 512 * j) * 4);
#pragma unroll
        for (int jj = 0; jj < 4; ++jj) {
            const int v0 = 16 * ((wave & 1) * 4 + jj) + 4 * fq;
            gwv[jj] = *(const f32x4*)(T.gnorm + v0);
            zs[jj] = *(const u32x2*)(T.ZS + (size_t)(R0 + tB) * HQK + h * 128 + v0);
        }
    }
    float run = 0.f;
#pragma unroll
    for (int i = 0; i < 16; ++i) { run += bb[i]; bb[i] = run; }
    SEG[sg * 128 + d] = run;
    {
        *(LAS u32x4*)(VT + d * TS + sg * 32) = (u32x4){vr[0] | (vr[1] << 16), vr[2] | (vr[3] << 16), vr[4] | (vr[5] << 16), vr[6] | (vr[7] << 16)};
        *(LAS u32x4*)(VT + d * TS + sg * 32 + 16) = (u32x4){vr[8] | (vr[9] << 16), vr[10] | (vr[11] << 16), vr[12] | (vr[13] << 16), vr[14] | (vr[15] << 16)};
    }
    if (PASS == 3) {
#pragma unroll
        for (int j = 0; j < 8; ++j) {
            const int idx = tid + 512 * j, v = idx >> 5, d4 = idx & 31;
            u32x2 o; o.x = pk2(s4[j][0], s4[j][1]); o.y = pk2(s4[j][2], s4[j][3]);
            *(LAS u32x2*)(SP + v * DS + d4 * 8) = o;
        }
    }
    __syncthreads();
    float pre = 0.f, tot = 0.f;
#pragma unroll
    for (int s = 0; s < 4; ++s) { const float v = SEG[s * 128 + d]; tot += v; if (s < sg) pre += v; }
#pragma unroll
    for (int i = 0; i < 16; ++i) bb[i] += pre;
    if (PASS == 1) {
        if (sg == 0) T.ADEC[(size_t)unit * 128 + d] = __expf(tot);
        unsigned pkk[8];
#pragma unroll
        for (int i = 0; i < 8; ++i) pkk[i] = pk2(bf2f(kr[2 * i]) * __expf(tot - bb[2 * i]), bf2f(kr[2 * i + 1]) * __expf(tot - bb[2 * i + 1]));
        *(LAS u32x4*)(SP + d * TS + sg * 32) = (u32x4){pkk[0], pkk[1], pkk[2], pkk[3]};
        *(LAS u32x4*)(SP + d * TS + sg * 32 + 16) = (u32x4){pkk[4], pkk[5], pkk[6], pkk[7]};
        __syncthreads();
        bf16x8 bfr[2];
#pragma unroll
        for (int ks = 0; ks < 2; ++ks) bfr[ks] = *(const LAS bf16x8*)(VT + (16 * wave + fr) * TS + (32 * ks + 8 * fq) * 2);
        float* stp = T.ST + (size_t)unit * 16384 + (size_t)(16 * wave + fr) * 128 + 4 * fq;
#pragma unroll
        for (int dt = 0; dt < 8; ++dt) {
            f32x4 acc = {0.f, 0.f, 0.f, 0.f};
#pragma unroll
            for (int ks = 0; ks < 2; ++ks) {
                const bf16x8 afr = *(const LAS bf16x8*)(SP + (16 * dt + fr) * TS + (32 * ks + 8 * fq) * 2);
                acc = __builtin_amdgcn_mfma_f32_16x16x32_bf16(afr, bfr[ks], acc, 0, 0, 0);
            }
            *(f32x4*)(stp + 16 * dt) = acc;
        }
        __syncthreads();
    } else {
#pragma unroll
        for (int i = 0; i < 16; ++i) {
            const float e = __expf(bb[i]);
            const float qt = bf2f(qr[i]) * e;
            const float kt = bf2f(kr[i]) * __builtin_amdgcn_rcpf(e);
            *(LAS bf16_t*)(QT + (sg * 16 + i) * DS + d * 2) = (bf16_t)(pk2(qt, 0.f) & 0xffffu);
            *(LAS bf16_t*)(KT + (sg * 16 + i) * DS + d * 2) = (bf16_t)(pk2(kt, 0.f) & 0xffffu);
        }
        __syncthreads();
        {
#pragma unroll
            for (int jj = 0; jj < 2; ++jj) {
                const int st = (wave & 1) * 2 + jj;
                f32x4 acc = {0.f, 0.f, 0.f, 0.f};
                if (st <= tt) {
#pragma unroll
                    for (int ks = 0; ks < 4; ++ks) {
                        const bf16x8 afr = *(const LAS bf16x8*)(KT + (16 * st + fr) * DS + (32 * ks + 8 * fq) * 2);
                        const bf16x8 bfr = *(const LAS bf16x8*)(QT + tB * DS + (32 * ks + 8 * fq) * 2);
                        acc = __builtin_amdgcn_mfma_f32_16x16x32_bf16(afr, bfr, acc, 0, 0, 0);
                    }
                    const int s0 = 16 * st + 4 * fq;
#pragma unroll
                    for (int r = 0; r < 4; ++r) if (s0 + r > tB) acc[r] = 0.f;
                }
                u32x2 o; o.x = pk2(acc[0], acc[1]); o.y = pk2(acc[2], acc[3]);
                *(LAS u32x2*)(AT + tB * TS + (16 * st + 4 * fq) * 2) = o;
            }
        }
        __syncthreads();
        {
            f32x4 o4[4]; float ssq = 0.f;
            bf16x8 ba[2], bq[4];
#pragma unroll
            for (int ks = 0; ks < 2; ++ks) ba[ks] = *(const LAS bf16x8*)(AT + tB * TS + (32 * ks + 8 * fq) * 2);
#pragma unroll
            for (int ks = 0; ks < 4; ++ks) bq[ks] = *(const LAS bf16x8*)(QT + tB * DS + (32 * ks + 8 * fq) * 2);
#pragma unroll
            for (int jj = 0; jj < 4; ++jj) {
                const int vt = (wave & 1) * 4 + jj;
                f32x4 acc = {0.f, 0.f, 0.f, 0.f};
#pragma unroll
                for (int ks = 0; ks < 2; ++ks) acc = __builtin_amdgcn_mfma_f32_16x16x32_bf16(*(const LAS bf16x8*)(VT + (16 * vt + fr) * TS + (32 * ks + 8 * fq) * 2), ba[ks], acc, 0, 0, 0);
#pragma unroll
                for (int ks = 0; ks < 4; ++ks) acc = __builtin_amdgcn_mfma_f32_16x16x32_bf16(*(const LAS bf16x8*)(SP + (16 * vt + fr) * DS + (32 * ks + 8 * fq) * 2), bq[ks], acc, 0, 0, 0);
                o4[jj] = acc;
                ssq += (acc[0] * acc[0] + acc[1] * acc[1]) + (acc[2] * acc[2] + acc[3] * acc[3]);
            }
            ssq += __shfl_xor(ssq, 16); ssq += __shfl_xor(ssq, 32);
            if (fq == 0) SSQ[(wave & 1) * 64 + tB] = ssq;
            __syncthreads();
            const float rinv = 1.0f / sqrtf((SSQ[tB] + SSQ[64 + tB]) * (1.0f / 128.0f) + EPS);
#pragma unroll
            for (int jj = 0; jj < 4; ++jj) {
                const int v0 = 16 * ((wave & 1) * 4 + jj) + 4 * fq;
                const f32x4 y = o4[jj] * rinv * gwv[jj] * (f32x4){bf2f(zs[jj].x & 0xffffu), bf2f(zs[jj].x >> 16), bf2f(zs[jj].y & 0xffffu), bf2f(zs[jj].y >> 16)};
                u32x2 o; o.x = pk2(y[0], y[1]); o.y = pk2(y[2], y[3]);
                *(u32x2*)(T.MIX + (size_t)(R0 + tB) * DM + PW + h * 128 + v0) = o;
            }
        }
        __syncthreads();
    }
}

__device__ __forceinline__ void scan_phase(float* ST, const float* ADEC, int tid) {
    for (int e = blockIdx.x * 512 + tid; e < 32 * 4096; e += gridDim.x * 512) {
        const int bh = e >> 12, within = e & 4095, d4 = within & 31;
        float* st = ST + (size_t)bh * 32 * 16384 + (size_t)within * 4;
        const float* ad = ADEC + (size_t)bh * 32 * 128 + d4 * 4;
        f32x4 S = {0.f, 0.f, 0.f, 0.f};
        for (int cb = 0; cb < 4; ++cb) {
            f32x4 L[8], A[8];
#pragma unroll
            for (int j = 0; j < 8; ++j) { L[j] = *(const f32x4*)(st + (size_t)(cb * 8 + j) * 16384); A[j] = *(const f32x4*)(ad + (cb * 8 + j) * 128); }
#pragma unroll
            for (int j = 0; j < 8; ++j) { *(f32x4*)(st + (size_t)(cb * 8 + j) * 16384) = S; S = A[j] * S + L[j]; }
        }
    }
}

__global__ void __launch_bounds__(512, 2) fwd_megakernel(Args a) {
    extern __shared__ __attribute__((aligned(16))) unsigned char lds_raw[];
    LAS unsigned char* lds = (LAS unsigned char*)lds_raw;
    cg::grid_group grid = cg::this_grid();
    const int tid = threadIdx.x, lane = tid & 63, wave = __builtin_amdgcn_readfirstlane(tid >> 6);
    const int G = gridDim.x, gw = blockIdx.x * 8 + wave, ngw = G * 8;
    unsigned char* ws = a.ws;
    if (tid < 16) ((LAS unsigned*)(lds + LDS_MISC))[tid] = 0u;
    __syncthreads();
    const XcdBarrier xbar = xcd_barrier_post((unsigned*)(ws + WS_BAR), (volatile LAS unsigned*)(lds + LDS_MISC));
    float* mod = (float*)(ws + WS_MOD); float* lbv = (float*)(ws + WS_LB);
    bf16_t* H = (bf16_t*)(ws + WS_H); float* X = (float*)(ws + WS_X); bf16_t* MIX = (bf16_t*)(ws + WS_MIX); bf16_t* HID = (bf16_t*)(ws + WS_HID);

    const int lo = a.ph_lo, hi = a.ph_hi;
#define IN(k) (lo <= (k) && (k) < hi)
#define SEAM(k) do { if ((k) + 1 < hi) xcd_barrier(xbar); } while (0)
    if (hi > NPH) grid.sync();
    if (IN(PH_PRO)) {
#ifndef SKIP_PRO
      for (int rep = 0; rep < REP_PRO; ++rep) { if (rep) grid.sync();
        p0_mod(a, lds, mod, tid, wave, lane);
        if (blockIdx.x == 0) {
            const float* l = a.in[12];
            for (int j = tid; j < HQK; j += 512) {
                const float l0 = l[j], l1 = l[HQK + j], m = fmaxf(l0, l1), e0 = __expf(l0 - m), e1 = __expf(l1 - m), s = e0 + e1, p0 = e0 / s, p1 = e1 / s;
                lbv[j] = (p0 + p1) - p0;
            }
        }
        weight_copies<0>(a, ws, gw, ngw, lane);
      }
#endif
        SEAM(PH_PRO);
    }
    if (IN(PH_N1)) { for (int rep = 0; rep < REP_N1; ++rep) { if (rep) grid.sync(); norm_phase<0>(a.in[0], a.in[4], mod + 0 * DM, mod + 1 * DM, H, nullptr, gw, ngw, lane); } SEAM(PH_N1); }
    if (IN(PH_GU1)) {
#ifndef SKIP_GU
        pg8::Gemm g{H, (const bf16_t*)(ws + WS_WGU1), MT, 2 * DFF, DM};
        pg8::StaticOrder S; S.init(MT, 2 * DFF, G, (int)blockIdx.x);
        pg8::EpiSwiglu E{HID, DFF};
        for (int rep = 0; rep < REP_GU1; ++rep) { if (rep) grid.sync();
        pg8::gemm_phase<pg8::EpiSwiglu, pg8::StaticOrder, true, true>(lds, g, S, E); }
#endif
        weight_copies_by_idle<1>(a, ws, (MT / 256) * (2 * DFF / 256), G, wave, lane);
        SEAM(PH_GU1);
    }
    if (IN(PH_DN1)) {
#ifndef SKIP_DN
        pg8::Gemm g{HID, (const bf16_t*)(ws + WS_WD1), MT, DM, DFF};
        pg8::StaticOrder S; S.init(MT, DM, G, (int)blockIdx.x);
        pg8::EpiResid E{a.in[0], X, mod + 2 * DM, 0.5f};
        for (int rep = 0; rep < REP_DN1; ++rep) { if (rep) grid.sync();
        pg8::gemm_phase<pg8::EpiResid, pg8::StaticOrder, true, true>(lds, g, S, E); }
#endif
        SEAM(PH_DN1);
    }
    if (IN(PH_N2)) { norm_phase<0>(X, a.in[8], mod + 3 * DM, mod + 4 * DM, H, nullptr, gw, ngw, lane); SEAM(PH_N2); }
    if (IN(PH_WIN)) {
#ifndef SKIP_WIN
        pg8::Gemm g{H, (const bf16_t*)(ws + WS_WIN), MT, INW, DM};
        pg8::StaticOrder S; S.init(MT, INW, G, (int)blockIdx.x);
        pg8::EpiWin E{(bf16_t*)(ws + WS_ZP), (bf16_t*)(ws + WS_ZQ), (bf16_t*)(ws + WS_ZK), (bf16_t*)(ws + WS_ZV), (bf16_t*)(ws + WS_ZS), (float*)(ws + WS_ZG), lbv};
        for (int rep = 0; rep < REP_WIN; ++rep) { if (rep) grid.sync();
        pg8::gemm_phase<pg8::EpiWin, pg8::StaticOrder, true, true>(lds, g, S, E); }
#endif
        weight_copies_by_idle<2>(a, ws, (MT / 256) * (INW / 256), G, wave, lane);
        SEAM(PH_WIN);
    }
#ifndef SKIP_MIX
    if (IN(PH_MIXA)) {
        HgrnT T{(const bf16_t*)(ws + WS_ZQ), (const bf16_t*)(ws + WS_ZK), (const bf16_t*)(ws + WS_ZV), (const bf16_t*)(ws + WS_ZS), (const float*)(ws + WS_ZG),
                (float*)(ws + WS_ST), (float*)(ws + WS_ADEC), a.in[13], MIX};
        for (int rep = 0; rep < REP_MIXA; ++rep) { if (rep) grid.sync();
        for (int it = blockIdx.x; it < 1024 + 512; it += G) {
            if (it < 1024) hgrn_unit<1>(T, lds, it, tid, wave, lane);
            else pool_unit((const bf16_t*)(ws + WS_ZP), (const bf16_t*)(ws + WS_PWT), a.in[11], MIX, lds, it - 1024, tid, wave, lane);
        } }
        SEAM(PH_MIXA);
    }
    if (IN(PH_SCAN)) { scan_phase((float*)(ws + WS_ST), (const float*)(ws + WS_ADEC), tid); SEAM(PH_SCAN); }
    if (IN(PH_MIXB)) {
        HgrnT T{(const bf16_t*)(ws + WS_ZQ), (const bf16_t*)(ws + WS_ZK), (const bf16_t*)(ws + WS_ZV), (const bf16_t*)(ws + WS_ZS), (const float*)(ws + WS_ZG),
                (float*)(ws + WS_ST), (float*)(ws + WS_ADEC), a.in[13], MIX};
        for (int rep = 0; rep < REP_MIXB; ++rep) { if (rep) grid.sync();
        for (int it = blockIdx.x; it < 1024; it += G) hgrn_unit<3>(T, lds, it, tid, wave, lane); }
        SEAM(PH_MIXB);
    }
#endif
    if (IN(PH_WOUT)) {
#ifndef SKIP_DN
        pg8::Gemm g{MIX, (const bf16_t*)(ws + WS_WOUT), MT, DM, DM};
        pg8::StaticOrder S; S.init(MT, DM, G, (int)blockIdx.x);
        pg8::EpiResid E{X, X, mod + 5 * DM, 1.0f};
        pg8::gemm_phase<pg8::EpiResid, pg8::StaticOrder, true, true>(lds, g, S, E);
#endif
        SEAM(PH_WOUT);
    }
    if (IN(PH_N3)) { norm_phase<0>(X, a.in[15], mod + 6 * DM, mod + 7 * DM, H, nullptr, gw, ngw, lane); SEAM(PH_N3); }
    if (IN(PH_GU2)) {
#ifndef SKIP_GU
        pg8::Gemm g{H, (const bf16_t*)(ws + WS_WGU2), MT, 2 * DFF, DM};
        pg8::StaticOrder S; S.init(MT, 2 * DFF, G, (int)blockIdx.x);
        pg8::EpiSwiglu E{HID, DFF};
        pg8::gemm_phase<pg8::EpiSwiglu, pg8::StaticOrder, true, true>(lds, g, S, E);
#endif
        SEAM(PH_GU2);
    }
    if (IN(PH_DN2)) {
#ifndef SKIP_DN
        pg8::Gemm g{HID, (const bf16_t*)(ws + WS_WD2), MT, DM, DFF};
        pg8::StaticOrder S; S.init(MT, DM, G, (int)blockIdx.x);
        pg8::EpiResid E{X, X, mod + 8 * DM, 0.5f};
        pg8::gemm_phase<pg8::EpiResid, pg8::StaticOrder, true, true>(lds, g, S, E);
#endif
        SEAM(PH_DN2);
    }
    if (IN(PH_FIN)) norm_phase<1>(X, a.in[19], nullptr, nullptr, nullptr, a.out, gw, ngw, lane);
#undef IN
#undef SEAM
}

extern "C" void kernel_launch(void* const* d_in, const int* in_sizes, int n_in, void* d_out, int out_size, void* d_ws, size_t ws_size, hipStream_t stream) {
    static int grid = 0;
    if (grid == 0) {
        if (n_in != 20 || in_sizes[0] != MT * DM || out_size != MT * DM || ws_size < WS_END) {
            fprintf(stderr, "kernel_launch: unexpected problem (n_in %d, in0 %d, out %d, ws %zu); nothing launched\n", n_in, n_in > 0 ? in_sizes[0] : -1, out_size, ws_size); grid = -1; return; }
        int dev = 0, cus = 0, per_cu = 0;
        if (hipGetDevice(&dev) != hipSuccess || hipDeviceGetAttribute(&cus, hipDeviceAttributeMultiprocessorCount, dev) != hipSuccess) { grid = -1; return; }
        if (hipFuncSetAttribute((const void*)fwd_megakernel, hipFuncAttributeMaxDynamicSharedMemorySize, LDS_BYTES) != hipSuccess) { fprintf(stderr, "kernel_launch: hipFuncSetAttribute failed\n"); grid = -1; return; }
        if (hipOccupancyMaxActiveBlocksPerMultiprocessor(&per_cu, (const void*)fwd_megakernel, 512, LDS_BYTES) != hipSuccess || per_cu < 1) { fprintf(stderr, "kernel_launch: occupancy query failed (%d)\n", per_cu); (void)hipGetLastError(); grid = -1; return; }
        grid = cus * per_cu;
    }
    if (grid < 0) return;
    if (hipMemsetAsync((unsigned char*)d_ws + WS_BAR, 0, XCD_BAR_WORDS * 4, stream) != hipSuccess) { fprintf(stderr, "kernel_launch: memset of the barrier words failed\n"); return; }
    Args a{};
    for (int i = 0; i < 20; ++i) a.in[i] = (const float*)d_in[i];
    a.out = (float*)d_out; a.ws = (unsigned char*)d_ws;
    for (int li = 0; li < MK_N_LAUNCHES; ++li) {
        a.ph_lo = (MK_N_LAUNCHES == 1) ? 0 : li; a.ph_hi = (MK_N_LAUNCHES == 1) ? NPH : li + 1;
        void* args[] = {&a};
        const hipError_t e = hipLaunchCooperativeKernel((const void*)fwd_megakernel, dim3(grid), dim3(512), args, LDS_BYTES, stream);
        if (e != hipSuccess) { fprintf(stderr, "kernel_launch: cooperative launch failed: %s (grid %d)\n", hipGetErrorString(e), grid); break; }
    }
}
```
